# Optimizing an MI355X kernel written in HIP

```python
import math
import jax, jax.numpy as jnp
from jax import lax
import numpy as np

D_MODEL = 1024
BATCH = 2
SEQ = 8192
DEPTH = 1

GRID_W = 64
HEAD_DIM = 64
NA_HEADS = 8
NA_KH_MAX = 8
NA_KW = 16
NA_WIDTH = NA_HEADS * HEAD_DIM
SWA_Q_HEADS = 8
SWA_KV_HEADS = 2
SWA_WINDOW = 128
SWA_BLOCK = 128
SWA_Q_WIDTH = SWA_Q_HEADS * HEAD_DIM
SWA_KV_WIDTH = SWA_KV_HEADS * HEAD_DIM
ROPE_THETA = 500000.0
ROPE_DIM = HEAD_DIM // 4
D_FF = 4 * D_MODEL
IN_WIDTH = 3 * NA_WIDTH + SWA_Q_WIDTH + 2 * SWA_KV_WIDTH + 2 * D_MODEL
IN_SPLITS = [
    NA_WIDTH,
    2 * NA_WIDTH,
    3 * NA_WIDTH,
    3 * NA_WIDTH + SWA_Q_WIDTH,
    3 * NA_WIDTH + SWA_Q_WIDTH + SWA_KV_WIDTH,
    3 * NA_WIDTH + SWA_Q_WIDTH + 2 * SWA_KV_WIDTH,
    3 * NA_WIDTH + SWA_Q_WIDTH + 2 * SWA_KV_WIDTH + D_MODEL,
]
DEEPNORM_ALPHA = (2.0 * DEPTH) ** 0.25
DEEPNORM_BETA = (8.0 * DEPTH) ** -0.25
LN_EPS = 1e-5
MASK_VALUE = -1e30

kernel_name = "hybrid_natten_swa_gated_deepnorm_encoder"


def layer_norm(x, g, b):
    xf = x.astype(jnp.float32)
    mu = jnp.mean(xf, axis=-1, keepdims=True)
    xc = xf - mu
    var = jnp.mean(xc * xc, axis=-1, keepdims=True)
    y = xc * lax.rsqrt(var + LN_EPS) * g.astype(jnp.float32) + b.astype(jnp.float32)
    return y.astype(x.dtype)


def partial_rotary(x, pos):
    half = ROPE_DIM // 2
    inv_freq = jnp.power(ROPE_THETA, -jnp.arange(0, ROPE_DIM, 2, dtype=jnp.float32) / ROPE_DIM)
    ang = pos.astype(jnp.float32)[:, None] * inv_freq[None, :]
    cos = jnp.cos(ang)[:, None, :]
    sin = jnp.sin(ang)[:, None, :]
    xr = x[..., :ROPE_DIM].astype(jnp.float32)
    x1, x2 = xr[..., :half], xr[..., half:]
    rot = jnp.concatenate([x1 * cos - x2 * sin, x2 * cos + x1 * sin], axis=-1)
    return jnp.concatenate([rot.astype(x.dtype), x[..., ROPE_DIM:]], axis=-1)


def neighbourhood_attention(q, k, v, rpb):
    B, S, H, Dh = q.shape
    rows = S // GRID_W
    kh = min(NA_KH_MAX, rows)
    kw = NA_KW
    qg = q.reshape(B, rows, GRID_W, H, Dh)
    kg = k.reshape(B, rows, GRID_W, H, Dh)
    vg = v.reshape(B, rows, GRID_W, H, Dh)
    cols = jnp.arange(GRID_W)
    col_start = jnp.clip(cols - kw // 2, 0, GRID_W - kw)
    col_idx = col_start[:, None] + jnp.arange(kw)[None, :]
    dc = col_idx - cols[:, None]
    scale = Dh ** -0.5

    def one_row(r):
        rs = jnp.clip(r - kh // 2, 0, rows - kh)
        kr = lax.dynamic_slice_in_dim(kg, rs, kh, axis=1)
        vr = lax.dynamic_slice_in_dim(vg, rs, kh, axis=1)
        kn = kr[:, :, col_idx]
        vn = vr[:, :, col_idx]
        qr = lax.dynamic_index_in_dim(qg, r, axis=1, keepdims=False)
        s = jnp.einsum('bwhd,bkwjhd->bhwkj', qr, kn).astype(jnp.float32) * scale
        dr = rs + jnp.arange(kh) - r
        bias = rpb[:, (dr + NA_KH_MAX - 1)[None, :, None], (dc + kw - 1)[:, None, :]]
        s = s + bias.astype(jnp.float32)[None]
        p = jax.nn.softmax(s.reshape(B, H, GRID_W, kh * kw), axis=-1)
        p = p.reshape(B, H, GRID_W, kh, kw).astype(v.dtype)
        return jnp.einsum('bhwkj,bkwjhd->bwhd', p, vn)

    out = lax.map(one_row, jnp.arange(rows))
    return jnp.moveaxis(out, 0, 1).reshape(B, S, H * Dh)


def windowed_gqa_with_sink(q, k, v, sink):
    B, S, Hq, Dh = q.shape
    G = k.shape[2]
    rep = Hq // G
    blk = SWA_BLOCK
    nb = S // blk
    qb = q.reshape(B, nb, blk, G, rep, Dh)
    pad = ((0, 0), (blk, blk), (0, 0), (0, 0))
    kp = jnp.pad(k, pad).reshape(B, nb + 2, blk, G, Dh)
    vp = jnp.pad(v, pad).reshape(B, nb + 2, blk, G, Dh)
    kb = jnp.concatenate([kp[:, :-2], kp[:, 1:-1], kp[:, 2:]], axis=2)
    vb = jnp.concatenate([vp[:, :-2], vp[:, 1:-1], vp[:, 2:]], axis=2)
    s = jnp.einsum('bnqgrd,bnkgd->bngrqk', qb, kb).astype(jnp.float32) * (Dh ** -0.5)
    qpos = jnp.arange(nb)[:, None] * blk + jnp.arange(blk)[None, :]
    kpos = jnp.arange(nb)[:, None] * blk - blk + jnp.arange(3 * blk)[None, :]
    rel = kpos[:, None, :] - qpos[:, :, None]
    valid = (jnp.abs(rel) <= SWA_WINDOW) & (kpos[:, None, :] >= 0) & (kpos[:, None, :] < S)
    s = jnp.where(valid[None, :, None, None], s, MASK_VALUE)
    sink_l = sink.astype(jnp.float32).reshape(1, 1, G, rep, 1, 1)
    m = jnp.maximum(jnp.max(s, axis=-1, keepdims=True), sink_l)
    e = jnp.exp(s - m)
    p = e / (jnp.sum(e, axis=-1, keepdims=True) + jnp.exp(sink_l - m))
    o = jnp.einsum('bngrqk,bnkgd->bnqgrd', p.astype(v.dtype), vb)
    return o.reshape(B, S, Hq * Dh)


def setup_inputs(seed: int = 0) -> dict:
    key = jax.random.key(seed)
    ks = jax.random.split(key, 24)
    f32 = jnp.float32
    beta = DEEPNORM_BETA

    def nrm(k, shape, scale):
        return jax.random.normal(k, shape, f32) * scale

    col_scale = jnp.concatenate([
        jnp.ones((2 * NA_WIDTH,), f32), jnp.full((NA_WIDTH,), beta, f32),
        jnp.ones((SWA_Q_WIDTH + SWA_KV_WIDTH,), f32), jnp.full((SWA_KV_WIDTH,), beta, f32),
        jnp.ones((2 * D_MODEL,), f32)])
    w_in = nrm(ks[1], (DEPTH, D_MODEL, IN_WIDTH), D_MODEL ** -0.5) * col_scale
    return {
        "x": jax.random.normal(ks[0], (BATCH, SEQ, D_MODEL), f32),
        "ln0_g": 1.0 + nrm(ks[2], (D_MODEL,), 0.05),
        "ln0_b": nrm(ks[3], (D_MODEL,), 0.02),
        "w_in": w_in,
        "b_in": nrm(ks[4], (DEPTH, IN_WIDTH), 0.02),
        "na_rpb": nrm(ks[5], (DEPTH, NA_HEADS, 2 * NA_KH_MAX - 1, 2 * NA_KW - 1), 0.1),
        "swa_sink": nrm(ks[6], (DEPTH, SWA_Q_HEADS), 0.5),
        "w_branch_na": nrm(ks[7], (DEPTH, NA_WIDTH, D_MODEL), NA_WIDTH ** -0.5 * beta),
        "w_branch_swa": nrm(ks[8], (DEPTH, SWA_Q_WIDTH, D_MODEL), SWA_Q_WIDTH ** -0.5 * beta),
        "w_out": nrm(ks[9], (DEPTH, D_MODEL, D_MODEL), D_MODEL ** -0.5 * beta),
        "b_out": nrm(ks[10], (DEPTH, D_MODEL), 0.02),
        "ln1_g": 1.0 + nrm(ks[11], (DEPTH, D_MODEL), 0.05),
        "ln1_b": nrm(ks[12], (DEPTH, D_MODEL), 0.02),
        "w_ff1": nrm(ks[13], (DEPTH, D_MODEL, D_FF), D_MODEL ** -0.5 * beta),
        "b_ff1": nrm(ks[14], (DEPTH, D_FF), 0.02),
        "w_ff2": nrm(ks[15], (DEPTH, D_FF, D_MODEL), D_FF ** -0.5 * beta),
        "b_ff2": nrm(ks[16], (DEPTH, D_MODEL), 0.02),
        "ln2_g": 1.0 + nrm(ks[17], (DEPTH, D_MODEL), 0.05),
        "ln2_b": nrm(ks[18], (DEPTH, D_MODEL), 0.02),
    }


def reference(x, ln0_g, ln0_b, w_in, b_in, na_rpb, swa_sink, w_branch_na, w_branch_swa,
              w_out, b_out, ln1_g, ln1_b, w_ff1, b_ff1, w_ff2, b_ff2, ln2_g, ln2_b):
    B, S, _ = x.shape
    pos = jnp.arange(S)
    h = layer_norm(x, ln0_g, ln0_b)
    for l in range(DEPTH):
        proj = h @ w_in[l] + b_in[l]
        qa, ka, va, qb, kb, vb, ga, gb = jnp.split(proj, IN_SPLITS, axis=-1)
        qa = qa.reshape(B, S, NA_HEADS, HEAD_DIM)
        ka = ka.reshape(B, S, NA_HEADS, HEAD_DIM)
        va = va.reshape(B, S, NA_HEADS, HEAD_DIM)
        qb = partial_rotary(qb.reshape(B, S, SWA_Q_HEADS, HEAD_DIM), pos)
        kb = partial_rotary(kb.reshape(B, S, SWA_KV_HEADS, HEAD_DIM), pos)
        vb = vb.reshape(B, S, SWA_KV_HEADS, HEAD_DIM)
        y_na = neighbourhood_attention(qa, ka, va, na_rpb[l]) @ w_branch_na[l]
        y_swa = windowed_gqa_with_sink(qb, kb, vb, swa_sink[l]) @ w_branch_swa[l]
        mixed = jax.nn.sigmoid(ga) * y_na + jax.nn.sigmoid(gb) * y_swa
        attn_out = mixed @ w_out[l] + b_out[l]
        h = layer_norm(DEEPNORM_ALPHA * h + attn_out, ln1_g[l], ln1_b[l])
        u = jnp.square(jax.nn.relu(h @ w_ff1[l] + b_ff1[l]))
        ffn_out = u @ w_ff2[l] + b_ff2[l]
        h = layer_norm(DEEPNORM_ALPHA * h + ffn_out, ln2_g[l], ln2_b[l])
    return h
```

```cpp
#include <hip/hip_runtime.h>
#include <cstdio>
#include <cstdint>
namespace pg8 {
#define PG8_LAS __attribute__((address_space(3)))
typedef unsigned short bf16_t;
typedef short bf16x8 __attribute__((ext_vector_type(8)));
typedef float f32x4 __attribute__((ext_vector_type(4)));
typedef unsigned u32x4 __attribute__((ext_vector_type(4)));
constexpr int BM = 256, BK = 64, HALF = 128, HTB = HALF * BK * 2  , STAGE_BYTES = 8 * HTB, NXCD = 8, WGM = 8;

__host__ __device__ __forceinline__ int lds_byte(int r, int c) { const int st = (r >> 4) * 2 + (c >> 5), rr = r & 15, cc = c & 31, ob = rr * 64 + cc * 2; return st * 1024 + (ob ^ (((ob >> 9) & 1) << 5)); }
__host__ __device__ __forceinline__ void stage_rc(int b, int& R, int& C) { const int st = b / 1024, sb = b % 1024, swz = sb ^ (((sb >> 9) & 1) << 5); R = (st >> 1) * 16 + swz / 64; C = (st & 1) * 32 + (swz % 64) / 2; }
__host__ __device__ __forceinline__ int perm32(int rho) { const int n = rho >> 4, i = rho & 15; return 8 * (i >> 2) + 4 * n + (i & 3); }

struct Unit { int pm, pn; };
struct Gemm { const bf16_t* A; const bf16_t* Bt; int M, N, K; };

struct StaticOrder {
    int nM, nN, nwg, G, c;
    __host__ __device__ void init(int M, int N, int G_, int c_) { nM = M / BM; nN = N / BM; nwg = nM * nN; G = G_; c = c_; }
    __host__ __device__ bool next(int i, Unit& u) const {
        const long L = (long)i * G + c; if (L >= nwg) return false;
        int wgid = (int)L; { const int q = nwg / NXCD, r = nwg % NXCD, xcd = wgid % NXCD, off = wgid / NXCD; wgid = (xcd < r ? xcd * (q + 1) : r * (q + 1) + (xcd - r) * q) + off; }
        const int nig = WGM * nN, gid = wgid / nig, fm = gid * WGM, gsz = (nM - fm) < WGM ? (nM - fm) : WGM;
        u.pm = fm + ((wgid % nig) % gsz); u.pn = (wgid % nig) / gsz; return true;
    }
    __device__ __forceinline__ void a_ready(const Unit&) const {}
    __device__ __forceinline__ void done(const Unit&) const {}
};

__device__ __forceinline__ unsigned cvt_pk_bf16(float lo, float hi) { unsigned r; asm volatile("v_cvt_pk_bf16_f32 %0, %1, %2" : "=v"(r) : "v"(lo), "v"(hi)); return r; }
typedef float f32x2 __attribute__((ext_vector_type(2)));
__device__ __forceinline__ f32x2 gelu_pk(f32x2 v) {
    const f32x2 av = __builtin_elementwise_abs(v), d = av * 0.2316418882f + 1.0f;
    f32x2 t; t.x = __builtin_amdgcn_rcpf(d.x); t.y = __builtin_amdgcn_rcpf(d.y);
    f32x2 q = t * 0.5307027145f + (-0.7265760135f); q = q * t + 0.7107068705f; q = q * t + (-0.142248368f); q = q * t + 0.127414796f; q = q * t;
    const f32x2 s = (v * v) * (-0.72134752044f);
    f32x2 e; e.x = __builtin_amdgcn_exp2f(s.x); e.y = __builtin_amdgcn_exp2f(s.y);
    const f32x2 m = v * (q * e), r = v - m;
    f32x2 o; o.x = v.x < 0.f ? m.x : r.x; o.y = v.y < 0.f ? m.y : r.y; return o;
}

template <int ACT  > struct EpiBf16 {
    static constexpr bool PERM = true, AFTER_DRAIN = false; static_assert(ACT == 0 || ACT == 1, "EpiBf16: ACT is 0 (none) or 1 (gelu_pk)");
    bf16_t* O; int ldc; const float* bias; int split_cols; size_t split_stride; float scale0;
    __device__ __forceinline__ void operator()(const f32x4 (&acc)[2][2][4][2], const Unit& u, int wr, int wc, int fr, int fq) const {
        const int row0 = u.pm * BM + wr * 64 + fr; int colt = u.pn * BM; bf16_t* base = O;
        float sc = 1.f; if (split_cols) { const int t = colt / split_cols; base += (size_t)t * split_stride; colt -= t * split_cols; if (t == 0) sc = scale0; }
        const int col0 = colt + wc * 32 + 8 * fq, bcol0 = u.pn * BM + wc * 32 + 8 * fq;
        f32x4 bv[2][2];
#pragma unroll
        for (int bj = 0; bj < 2; ++bj)
#pragma unroll
            for (int n = 0; n < 2; ++n) bv[bj][n] = bias ? *(const f32x4*)(bias + bcol0 + bj * HALF + 4 * n) : (f32x4){0.f, 0.f, 0.f, 0.f};
#pragma unroll
        for (int ai = 0; ai < 2; ++ai)
#pragma unroll
            for (int m = 0; m < 4; ++m) { bf16_t* rowp = base + (size_t)(row0 + ai * HALF + m * 16) * ldc + col0;
#pragma unroll
                for (int bj = 0; bj < 2; ++bj) { f32x4 v0 = acc[ai][bj][m][0] + bv[bj][0], v1 = acc[ai][bj][m][1] + bv[bj][1];
                    if (ACT == 1) { f32x2 a = gelu_pk((f32x2){v0[0], v0[1]}), b = gelu_pk((f32x2){v0[2], v0[3]}), c = gelu_pk((f32x2){v1[0], v1[1]}), d = gelu_pk((f32x2){v1[2], v1[3]});
                        v0 = (f32x4){a.x, a.y, b.x, b.y}; v1 = (f32x4){c.x, c.y, d.x, d.y}; }
                    v0 = v0 * sc; v1 = v1 * sc; u32x4 w; w.x = cvt_pk_bf16(v0[0], v0[1]); w.y = cvt_pk_bf16(v0[2], v0[3]); w.z = cvt_pk_bf16(v1[0], v1[1]); w.w = cvt_pk_bf16(v1[2], v1[3]);
                    *(u32x4*)(rowp + bj * HALF) = w; } }
    }
};

struct PanelStats {
    unsigned* xbuf;
    unsigned* cnt;
    unsigned* tmo;
    int ntn; float eps;
    unsigned code;
    __device__ __forceinline__ bool run(const f32x4 (&v)[2][2][4][2], const Unit& u, int wr, int wc, int fr, int fq, PG8_LAS unsigned char* lds, int wid, int lane) const {
        typedef float f32x2v __attribute__((ext_vector_type(2)));
        PG8_LAS f32x2v* P = (PG8_LAS f32x2v*)lds;
        PG8_LAS f32x2v* S = (PG8_LAS f32x2v*)(lds + 8192);
        PG8_LAS unsigned* flag = (PG8_LAS unsigned*)(lds + 8192 + 2048);
#pragma unroll
        for (int ai = 0; ai < 2; ++ai)
#pragma unroll
            for (int m = 0; m < 4; ++m) {
                float s = 0.f;
#pragma unroll
                for (int bj = 0; bj < 2; ++bj)
#pragma unroll
                    for (int n = 0; n < 2; ++n) { const f32x4 x = v[ai][bj][m][n]; s += (x[0] + x[1]) + (x[2] + x[3]); }
                s += __shfl_xor(s, 16); s += __shfl_xor(s, 32);
                const float mw = s * (1.0f / 64.0f); float q = 0.f;
#pragma unroll
                for (int bj = 0; bj < 2; ++bj)
#pragma unroll
                    for (int n = 0; n < 2; ++n) { const f32x4 d = v[ai][bj][m][n] - mw; q += (d[0] * d[0] + d[1] * d[1]) + (d[2] * d[2] + d[3] * d[3]); }
                q += __shfl_xor(q, 16); q += __shfl_xor(q, 32);
                if (fq == 0) P[(ai * HALF + wr * 64 + m * 16 + fr) * 4 + wc] = (f32x2v){mw, q};
            }
        asm volatile("s_waitcnt lgkmcnt(0)" ::: "memory"); __builtin_amdgcn_s_barrier(); asm volatile("" ::: "memory");
#if defined(BROKEN_EXCHANGE_NO_WAIT)
#warning BROKEN CONTROL BUILD: the row-statistics exchange does not wait; results are wrong by design
        if (blockIdx.x >= 64) { const long long t0_ = clock64(); while (clock64() - t0_ < 60000) __builtin_amdgcn_s_sleep(8); }
#endif
        const int row = wid * 32 + (lane & 31);
        if (lane < 32) {
            const f32x2v a = P[row * 4 + 0], b = P[row * 4 + 1], c = P[row * 4 + 2], d = P[row * 4 + 3];
            const float mt = (a.x + b.x + c.x + d.x) * 0.25f;
            const float da = a.x - mt, db = b.x - mt, dc = c.x - mt, dd = d.x - mt;
            const float m2 = (a.y + b.y) + (c.y + d.y) + 64.0f * ((da * da + db * db) + (dc * dc + dd * dd));
            unsigned long long* slot = (unsigned long long*)xbuf + ((size_t)(u.pm * BM + row) * 4 + u.pn);
            __hip_atomic_store(slot, ((unsigned long long)__float_as_uint(m2) << 32) | __float_as_uint(mt), __ATOMIC_RELAXED, __HIP_MEMORY_SCOPE_AGENT);
        }
        asm volatile("s_waitcnt vmcnt(0)" ::: "memory");
        if (lane == 0) __hip_atomic_fetch_add(cnt + 64 * u.pm, 1u, __ATOMIC_RELAXED, __HIP_MEMORY_SCOPE_AGENT);
        if (wid == 0) {
            bool dead = false; const unsigned long long t0 = __builtin_amdgcn_s_memrealtime(); const unsigned want = 8u * (unsigned)ntn;
            for (;;) {
#if defined(BROKEN_EXCHANGE_NO_WAIT)
                break;
#endif
                if ((unsigned)__builtin_amdgcn_readfirstlane(__hip_atomic_load(cnt + 64 * u.pm, __ATOMIC_RELAXED, __HIP_MEMORY_SCOPE_AGENT)) >= want) break;
                if (__builtin_amdgcn_s_memrealtime() - t0 > 2000000ull) {
                    if (lane == 0) { unsigned expect = 0u; __hip_atomic_compare_exchange_strong(tmo + 1, &expect, code | (unsigned)(u.pm & 0xff), __ATOMIC_RELAXED, __ATOMIC_RELAXED, __HIP_MEMORY_SCOPE_AGENT);
                                     __hip_atomic_store(tmo, 1u, __ATOMIC_RELAXED, __HIP_MEMORY_SCOPE_AGENT); }
                    dead = true; break; }
                __builtin_amdgcn_s_sleep(2);
            }
            __builtin_amdgcn_fence(__ATOMIC_ACQUIRE, "agent");
            if (lane == 0) flag[0] = dead ? 1u : 0u;
        }
        asm volatile("s_waitcnt vmcnt(0) lgkmcnt(0)" ::: "memory"); __builtin_amdgcn_s_barrier(); asm volatile("" ::: "memory");
        const bool bad = flag[0] != 0u;
        if (lane < 32) {
            const unsigned long long* slot = (const unsigned long long*)xbuf + (size_t)(u.pm * BM + row) * 4; float mt[4], m2[4]; float ms = 0.f;
#pragma unroll
            for (int t = 0; t < 4; ++t) { if (t < ntn) { const unsigned long long w = __hip_atomic_load(slot + t, __ATOMIC_RELAXED, __HIP_MEMORY_SCOPE_AGENT); mt[t] = __uint_as_float((unsigned)w); m2[t] = __uint_as_float((unsigned)(w >> 32)); } else { mt[t] = 0.f; m2[t] = 0.f; } ms += mt[t]; }
            const float mean = ms / (float)ntn; float q = 0.f;
#pragma unroll
            for (int t = 0; t < 4; ++t) if (t < ntn) { const float dm = mt[t] - mean; q += m2[t] + 256.0f * dm * dm; }
            S[row] = (f32x2v){mean, 1.0f / sqrtf(q / (256.0f * (float)ntn) + eps)};
        }
        asm volatile("s_waitcnt lgkmcnt(0)" ::: "memory"); __builtin_amdgcn_s_barrier(); asm volatile("" ::: "memory");
        return bad;
    }
};
struct EpiLnRes {
    static constexpr bool PERM = false, AFTER_DRAIN = true;
    const float* base; float* out; int ldc; const float* bias; PanelStats st; unsigned poison;
    __device__ __forceinline__ void fused(f32x4 (&acc)[2][2][4][2], const Unit& u, int wr, int wc, int fr, int fq, PG8_LAS unsigned char* lds, int wid, int lane) const {
        typedef float f32x2v __attribute__((ext_vector_type(2)));
        const PG8_LAS f32x2v* S = (const PG8_LAS f32x2v*)(lds + 8192);
        const int col0 = u.pn * BM + wc * 32 + 4 * fq;
#pragma unroll
        for (int bj = 0; bj < 2; ++bj)
#pragma unroll
            for (int n = 0; n < 2; ++n) { const f32x4 bv = bias ? *(const f32x4*)(bias + col0 + bj * HALF + n * 16) : (f32x4){0.f, 0.f, 0.f, 0.f};
#pragma unroll
                for (int ai = 0; ai < 2; ++ai)
#pragma unroll
                    for (int m = 0; m < 4; ++m) acc[ai][bj][m][n] += bv; }
        f32x4 pre[4][2][2];
#pragma unroll
        for (int m = 0; m < 4; ++m) { const size_t off = (size_t)(u.pm * BM + wr * 64 + m * 16 + fr) * ldc + col0;
#pragma unroll
            for (int bj = 0; bj < 2; ++bj)
#pragma unroll
                for (int n = 0; n < 2; ++n) pre[m][bj][n] = *(const f32x4*)(base + off + bj * HALF + n * 16); }
        const bool bad = st.run(acc, u, wr, wc, fr, fq, lds, wid, lane) || poison != 0u;
        const float qnan = __builtin_nanf("");
#pragma unroll
        for (int ai = 0; ai < 2; ++ai)
#pragma unroll
            for (int m = 0; m < 4; ++m) { const int r = ai * HALF + wr * 64 + m * 16 + fr; const f32x2v sr = S[r]; const size_t off = (size_t)(u.pm * BM + r) * ldc + col0;
#pragma unroll
                for (int bj = 0; bj < 2; ++bj)
#pragma unroll
                    for (int n = 0; n < 2; ++n) { const f32x4 bs = ai == 0 ? pre[m][bj][n] : *(const f32x4*)(base + off + bj * HALF + n * 16); f32x4 o = bs + (acc[ai][bj][m][n] - sr.x) * sr.y;
                        if (bad) o = (f32x4){qnan, qnan, qnan, qnan}; *(f32x4*)(out + off + bj * HALF + n * 16) = o; }
                if (m & 1) asm volatile("" ::: "memory"); }
    }
};
struct EpiLnResLn {
    static constexpr bool PERM = false, AFTER_DRAIN = true;
    const float* base; float* out; bf16_t* xn; int ldc; const float* bias; PanelStats st1, st2; unsigned poison;
    __device__ __forceinline__ void fused(f32x4 (&acc)[2][2][4][2], const Unit& u, int wr, int wc, int fr, int fq, PG8_LAS unsigned char* lds, int wid, int lane) const {
        typedef float f32x2v __attribute__((ext_vector_type(2))); typedef unsigned u32x2v __attribute__((ext_vector_type(2)));
        const PG8_LAS f32x2v* S = (const PG8_LAS f32x2v*)(lds + 8192);
        const int col0 = u.pn * BM + wc * 32 + 4 * fq;
#pragma unroll
        for (int bj = 0; bj < 2; ++bj)
#pragma unroll
            for (int n = 0; n < 2; ++n) { const f32x4 bv = bias ? *(const f32x4*)(bias + col0 + bj * HALF + n * 16) : (f32x4){0.f, 0.f, 0.f, 0.f};
#pragma unroll
                for (int ai = 0; ai < 2; ++ai)
#pragma unroll
                    for (int m = 0; m < 4; ++m) acc[ai][bj][m][n] += bv; }
        bool bad = st1.run(acc, u, wr, wc, fr, fq, lds, wid, lane) || poison != 0u;
        const float qnan = __builtin_nanf("");
#pragma unroll
        for (int ai = 0; ai < 2; ++ai)
#pragma unroll
            for (int m = 0; m < 4; ++m) { const int r = ai * HALF + wr * 64 + m * 16 + fr; const f32x2v sr = S[r]; const size_t off = (size_t)(u.pm * BM + r) * ldc + col0;
#pragma unroll
                for (int bj = 0; bj < 2; ++bj)
#pragma unroll
                    for (int n = 0; n < 2; ++n) { const f32x4 bs = *(const f32x4*)(base + off + bj * HALF + n * 16); acc[ai][bj][m][n] = bs + (acc[ai][bj][m][n] - sr.x) * sr.y; }
                asm volatile("" : "+v"(acc[ai][0][m][0]), "+v"(acc[ai][0][m][1]), "+v"(acc[ai][1][m][0]), "+v"(acc[ai][1][m][1]));
                if (m & 1) asm volatile("" ::: "memory"); }
        const bool bad1 = bad;
        bad = st2.run(acc, u, wr, wc, fr, fq, lds, wid, lane) || bad;
#pragma unroll
        for (int ai = 0; ai < 2; ++ai)
#pragma unroll
            for (int m = 0; m < 4; ++m) { const int r = ai * HALF + wr * 64 + m * 16 + fr; const f32x2v sr = S[r]; const size_t off = (size_t)(u.pm * BM + r) * ldc + col0;
#pragma unroll
                for (int bj = 0; bj < 2; ++bj)
#pragma unroll
                    for (int n = 0; n < 2; ++n) { const f32x4 x1 = acc[ai][bj][m][n]; *(f32x4*)(out + off + bj * HALF + n * 16) = bad1 ? (f32x4){qnan, qnan, qnan, qnan} : x1;
                        const f32x4 o = (x1 - sr.x) * sr.y; u32x2v w; w.x = cvt_pk_bf16(o[0], o[1]); w.y = cvt_pk_bf16(o[2], o[3]);
                        if (bad) { w.x = 0x7fc07fc0u; w.y = 0x7fc07fc0u; } *(u32x2v*)(xn + off + bj * HALF + n * 16) = w; }
                asm volatile("" ::: "memory"); }
    }
};

template <class Epi, class Sched, bool ALIGN_EPI = false, bool SP2 = false>
__device__ __forceinline__ void gemm_phase(PG8_LAS unsigned char* lds, const Gemm g, const Sched& S, const Epi& E) {
    const int tid = threadIdx.x, wid = __builtin_amdgcn_readfirstlane(tid >> 6), lane = tid & 63, wr = wid >> 2, wc = wid & 3, fr = lane & 15, fq = lane >> 4;
    const int K = g.K, nt = K / BK;
    unsigned voffA[2], voffB[2];
#pragma unroll
    for (int i = 0; i < 2; ++i) { int R, C; stage_rc(tid * 16 + i * 8192, R, C); const int Rb = Epi::PERM ? ((R & ~31) + perm32(R & 31)) : R;
        voffA[i] = (unsigned)(R * K + C) * 2u; voffB[i] = (unsigned)(Rb * K + C) * 2u; }
    const size_t kstep = (size_t)(BK * 2);
    const size_t hstep = (size_t)HALF * K * 2;
    const size_t tstep = 2 * hstep;
    const unsigned ldsw = (unsigned)wid * 1024u;
    const int aoff = lds_byte(wr * 64 + fr, fq * 8), boff = lds_byte(wc * 32 + fr, fq * 8);
#define PG8_SA(b, h) (((b) * 2 + (h)) * HTB)
#define PG8_SB(b, h) ((4 + (b) * 2 + (h)) * HTB)
#define PG8_STAGE(bufoff, gbase, voff) do { _Pragma("unroll") for (int _i = 0; _i < 2; ++_i) \
        __builtin_amdgcn_global_load_lds((const unsigned*)((const char*)(gbase) + (voff)[_i]), (PG8_LAS unsigned*)(lds + (bufoff) + ldsw + _i * 8192), 16, 0, 0); } while (0)
#define PG8_LDA(dst, b, h) do { _Pragma("unroll") for (int m = 0; m < 4; ++m) _Pragma("unroll") for (int k = 0; k < 2; ++k) dst[m][k] = *(const PG8_LAS bf16x8*)(lds + PG8_SA(b, h) + aoff + m * 2048 + k * 1024); } while (0)
#define PG8_LDB(dst, b, h) do { _Pragma("unroll") for (int n = 0; n < 2; ++n) _Pragma("unroll") for (int k = 0; k < 2; ++k) dst[n][k] = *(const PG8_LAS bf16x8*)(lds + PG8_SB(b, h) + boff + n * 2048 + k * 1024); } while (0)
#define PG8_MMA(ai, bj, At, Bt) do { __builtin_amdgcn_s_setprio(1); _Pragma("unroll") for (int m = 0; m < 4; ++m) _Pragma("unroll") for (int n = 0; n < 2; ++n) _Pragma("unroll") for (int k = 0; k < 2; ++k) \
        acc[ai][bj][m][n] = __builtin_amdgcn_mfma_f32_16x16x32_bf16(Bt[n][k], At[m][k], acc[ai][bj][m][n], 0, 0, 0); __builtin_amdgcn_s_setprio(0); } while (0)
#define PG8_WAIT_V(n) asm volatile("s_waitcnt vmcnt(" #n ")" ::: "memory")
#define PG8_WAIT_L(n) asm volatile("s_waitcnt lgkmcnt(" #n ")" ::: "memory")
#define PG8_BAR __builtin_amdgcn_s_barrier()
#define PG8_SCHED __builtin_amdgcn_sched_barrier(0)
    Unit cur, nxt; int ui = 0;
    if (!S.next(0, cur)) return;
    f32x4 acc[2][2][4][2];
#pragma unroll
    for (int a = 0; a < 2; ++a)
#pragma unroll
        for (int b = 0; b < 2; ++b)
#pragma unroll
            for (int m = 0; m < 4; ++m)
#pragma unroll
                for (int n = 0; n < 2; ++n) acc[a][b][m][n] = (f32x4){0.f, 0.f, 0.f, 0.f};
    bf16x8 At[4][2], B0[2][2], B1[2][2];
    const char* cA = (const char*)g.A + (size_t)cur.pm * tstep; const char* cB = (const char*)g.Bt + (size_t)cur.pn * tstep;
    S.a_ready(cur);
    if constexpr (SP2) {
        PG8_STAGE(PG8_SB(0, 0), cB, voffB); PG8_STAGE(PG8_SB(0, 1), cB + hstep, voffB); PG8_STAGE(PG8_SA(0, 0), cA, voffA); PG8_STAGE(PG8_SA(0, 1), cA + hstep, voffA);
        if (wr == 1) PG8_BAR;
        PG8_WAIT_V(2); PG8_BAR;
        PG8_STAGE(PG8_SB(1, 0), cB + kstep, voffB); PG8_STAGE(PG8_SA(1, 0), cA + kstep, voffA); PG8_STAGE(PG8_SB(1, 1), cB + hstep + kstep, voffB);
        PG8_WAIT_V(6); PG8_BAR;
    } else {
        PG8_STAGE(PG8_SB(0, 0), cB, voffB); PG8_STAGE(PG8_SA(0, 0), cA, voffA); PG8_STAGE(PG8_SB(0, 1), cB + hstep, voffB); PG8_STAGE(PG8_SA(0, 1), cA + hstep, voffA);
        if (wr == 1) PG8_BAR;
        PG8_WAIT_V(4); PG8_BAR;
        PG8_STAGE(PG8_SB(1, 0), cB + kstep, voffB); PG8_STAGE(PG8_SA(1, 0), cA + kstep, voffA); PG8_STAGE(PG8_SB(1, 1), cB + hstep + kstep, voffB);
        PG8_WAIT_V(6); PG8_BAR;
    }
    for (;;) {
        const bool has_next = S.next(ui + 1, nxt);
        const char* nA = has_next ? (const char*)g.A + (size_t)nxt.pm * tstep : cA; const char* nB = has_next ? (const char*)g.Bt + (size_t)nxt.pn * tstep : cB;
        for (int t = 0; t < nt; t += 2) {
            const bool last = (t == nt - 2);
            const char* a1 = cA + (size_t)(t + 1) * kstep;
            const char* a2 = last ? nA : cA + (size_t)(t + 2) * kstep; const char* b2 = last ? nB : cB + (size_t)(t + 2) * kstep;
            const char* a3 = a2 + kstep; const char* b3 = b2 + kstep;
            if (last && has_next) S.a_ready(nxt);
            if constexpr (SP2) {
            PG8_LDB(B0, 0, 0); PG8_LDB(B1, 0, 1); PG8_SCHED; PG8_LDA(At, 0, 0); PG8_STAGE(PG8_SA(1, 1), a1 + hstep, voffA);
            PG8_WAIT_V(8); PG8_WAIT_L(0); PG8_BAR; PG8_MMA(0, 0, At, B0); PG8_MMA(0, 1, At, B1); PG8_BAR; PG8_SCHED;
            PG8_LDA(At, 0, 1); PG8_STAGE(PG8_SB(0, 0), b2, voffB); PG8_STAGE(PG8_SB(0, 1), b2 + hstep, voffB); PG8_STAGE(PG8_SA(0, 0), a2, voffA);
            PG8_WAIT_V(8); PG8_WAIT_L(0); PG8_BAR; PG8_MMA(1, 0, At, B0); PG8_MMA(1, 1, At, B1); PG8_BAR; PG8_SCHED;
            PG8_LDB(B0, 1, 0); PG8_LDB(B1, 1, 1); PG8_SCHED; PG8_LDA(At, 1, 0); PG8_STAGE(PG8_SA(0, 1), a2 + hstep, voffA);
            PG8_WAIT_V(8); PG8_WAIT_L(0); PG8_BAR; PG8_MMA(0, 0, At, B0); PG8_MMA(0, 1, At, B1); PG8_BAR; PG8_SCHED;
            PG8_LDA(At, 1, 1); PG8_STAGE(PG8_SB(1, 0), b3, voffB); PG8_STAGE(PG8_SB(1, 1), b3 + hstep, voffB); PG8_STAGE(PG8_SA(1, 0), a3, voffA);
            PG8_WAIT_V(8); PG8_WAIT_L(0); PG8_BAR; PG8_MMA(1, 0, At, B0); PG8_MMA(1, 1, At, B1); PG8_BAR; PG8_SCHED;
            } else {
            PG8_LDB(B0, 0, 0); PG8_SCHED; PG8_LDA(At, 0, 0); PG8_STAGE(PG8_SA(1, 1), a1 + hstep, voffA);
            PG8_WAIT_L(8); PG8_BAR; PG8_WAIT_L(0); PG8_MMA(0, 0, At, B0); PG8_BAR; PG8_SCHED;
            PG8_LDB(B1, 0, 1); PG8_STAGE(PG8_SB(0, 0), b2, voffB);
            PG8_BAR; PG8_WAIT_L(0); PG8_MMA(0, 1, At, B1); PG8_BAR;
            PG8_LDA(At, 0, 1); PG8_STAGE(PG8_SA(0, 0), a2, voffA);
            PG8_BAR; PG8_WAIT_L(0); PG8_MMA(1, 0, At, B0); PG8_BAR; PG8_SCHED;
            PG8_STAGE(PG8_SB(0, 1), b2 + hstep, voffB);
            PG8_WAIT_V(6); PG8_BAR; PG8_MMA(1, 1, At, B1); PG8_BAR;
            PG8_LDB(B0, 1, 0); PG8_SCHED; PG8_LDA(At, 1, 0); PG8_STAGE(PG8_SA(0, 1), a2 + hstep, voffA);
            PG8_WAIT_L(8); PG8_BAR; PG8_WAIT_L(0); PG8_MMA(0, 0, At, B0); PG8_BAR; PG8_SCHED;
            PG8_LDB(B1, 1, 1); PG8_STAGE(PG8_SB(1, 0), b3, voffB);
            PG8_BAR; PG8_WAIT_L(0); PG8_MMA(0, 1, At, B1); PG8_BAR;
            PG8_LDA(At, 1, 1); PG8_STAGE(PG8_SA(1, 0), a3, voffA);
            PG8_BAR; PG8_WAIT_L(0); PG8_MMA(1, 0, At, B0); PG8_BAR; PG8_SCHED;
            PG8_STAGE(PG8_SB(1, 1), b3 + hstep, voffB);
            PG8_WAIT_V(6); PG8_BAR; PG8_MMA(1, 1, At, B1); PG8_BAR;
            }
        }
        if constexpr (ALIGN_EPI) { if (wr == 0) PG8_BAR; }
        if constexpr (!Epi::AFTER_DRAIN) { E(acc, cur, wr, wc, fr, fq); S.done(cur); }
        if (!has_next) break;
#pragma unroll
        for (int a = 0; a < 2; ++a)
#pragma unroll
            for (int b = 0; b < 2; ++b)
#pragma unroll
                for (int m = 0; m < 4; ++m)
#pragma unroll
                    for (int n = 0; n < 2; ++n) acc[a][b][m][n] = (f32x4){0.f, 0.f, 0.f, 0.f};
        cur = nxt; cA = nA; cB = nB; ++ui;
        if constexpr (ALIGN_EPI) { if (wr == 1) PG8_BAR; }
    }
    PG8_WAIT_V(0);
    if constexpr (!ALIGN_EPI) { if (wr == 0) PG8_BAR; }
    PG8_BAR;
    if constexpr (Epi::AFTER_DRAIN) { E.fused(acc, cur, wr, wc, fr, fq, lds, wid, lane); S.done(cur); }
#undef PG8_SA
#undef PG8_SB
#undef PG8_STAGE
#undef PG8_LDA
#undef PG8_LDB
#undef PG8_MMA
#undef PG8_WAIT_V
#undef PG8_WAIT_L
#undef PG8_BAR
#undef PG8_SCHED
}
}

#ifndef PG8_SP2
#define PG8_SP2 true
#endif
#ifndef PG8_ALIGN
#define PG8_ALIGN true
#endif
#include <hip/hip_cooperative_groups.h>
namespace cg = cooperative_groups;
#define NAIVE_ATTN 0

#define LAS __attribute__((address_space(3)))
typedef unsigned short bf16;
typedef unsigned v4u __attribute__((ext_vector_type(4)));
typedef unsigned v2u __attribute__((ext_vector_type(2)));
typedef float f32x4 __attribute__((ext_vector_type(4)));
typedef short bf16x8 __attribute__((ext_vector_type(8)));

constexpr int NWAVES = 8, NTHREADS = 512;
constexpr int SEQ = 8192, M = 16384, D = 1024, FF = 4096, NMAIN = 3840, NVA = 512, NIN = 4352;
constexpr float LN_EPS = 1e-5f;
constexpr float ALPHA = 1.189207115002721f;
constexpr size_t MiB = 1u << 20;
constexpr size_t WS_STATS = 0, WS_CS = 256 * 1024;
constexpr size_t WS_WIN = 1 * MiB;
constexpr size_t WS_WBNA = 10 * MiB, WS_WBSWA = 11 * MiB, WS_WOUT = 12 * MiB, WS_W1 = 14 * MiB, WS_W2 = 22 * MiB;
constexpr size_t WS_XN = 32 * MiB;
constexpr size_t WS_QA = 64 * MiB, WS_QB = 80 * MiB, WS_KA = 96 * MiB, WS_VAT = 112 * MiB, WS_KB = 128 * MiB, WS_VBT = 132 * MiB, WS_GA = 136 * MiB, WS_GB = 168 * MiB;
constexpr size_t WS_MIX = 96 * MiB;
constexpr size_t WS_U = 64 * MiB;
constexpr size_t WS_END = 200 * MiB;
constexpr int LDS_BYTES = 147456;

__device__ __forceinline__ float bf2f(unsigned h) { return __uint_as_float(h << 16); }
__device__ __forceinline__ unsigned pk2(float lo, float hi) { return pg8::cvt_pk_bf16(lo, hi); }
__device__ __forceinline__ float wave_sum(float v) {
#pragma unroll
    for (int o = 1; o < 64; o <<= 1) v += __shfl_xor(v, o);
    return v;
}
__device__ __forceinline__ f32x4 mfma16(bf16x8 a, bf16x8 b, f32x4 c) { return __builtin_amdgcn_mfma_f32_16x16x32_bf16(a, b, c, 0, 0, 0); }

__device__ __forceinline__ void transpose_item(const float* W, int K, int N, bf16* WT, int k0, int n0, int drow0, LAS float* scr, int lane) {
#pragma unroll 8
    for (int i = 0; i < 32; ++i) { const int kk = 2 * i + (lane >> 5); scr[kk * 33 + (lane & 31)] = W[(size_t)(k0 + kk) * N + n0 + (lane & 31)]; }
    asm volatile("s_waitcnt lgkmcnt(0)" ::: "memory");
    const int c = lane & 7;
#pragma unroll
    for (int j = 0; j < 4; ++j) { const int n = (lane >> 3) + 8 * j; const LAS float* s = scr + (8 * c) * 33 + n;
        v4u o; o.x = pk2(s[0 * 33], s[1 * 33]); o.y = pk2(s[2 * 33], s[3 * 33]); o.z = pk2(s[4 * 33], s[5 * 33]); o.w = pk2(s[6 * 33], s[7 * 33]);
        *(v4u*)(WT + (size_t)(drow0 + n) * K + k0 + 8 * c) = o; }
    asm volatile("s_waitcnt lgkmcnt(0)" ::: "memory");
}
template <bool WF32, bool WBF, bool WST>
__device__ __forceinline__ void ln_row(const float* xrow, const float* g, const float* b, float* of32, bf16* obf, float* stats, int lane) {
    const f32x4* xr = (const f32x4*)xrow + lane;
    f32x4 v[4]; float s = 0.f;
#pragma unroll
    for (int j = 0; j < 4; ++j) { v[j] = xr[64 * j]; s += (v[j].x + v[j].y) + (v[j].z + v[j].w); }
    const float mean = wave_sum(s) * (1.f / D); float s2 = 0.f;
#pragma unroll
    for (int j = 0; j < 4; ++j) { v[j] = v[j] - mean; s2 += (v[j].x * v[j].x + v[j].y * v[j].y) + (v[j].z * v[j].z + v[j].w * v[j].w); }
    const float rstd = 1.f / sqrtf(wave_sum(s2) * (1.f / D) + LN_EPS);
    if (WST) { if (lane == 0) { stats[0] = mean; stats[1] = rstd; } }
#pragma unroll
    for (int j = 0; j < 4; ++j) {
        const f32x4 gv = *((const f32x4*)g + lane + 64 * j), bv = *((const f32x4*)b + lane + 64 * j);
        const f32x4 y = v[j] * rstd * gv + bv;
        if (WF32) *((f32x4*)of32 + lane + 64 * j) = y;
        if (WBF) { v2u o; o.x = pk2(y.x, y.y); o.y = pk2(y.z, y.w); *((v2u*)obf + lane + 64 * j) = o; }
    }
}

struct EpiProj {
    static constexpr bool PERM = true, AFTER_DRAIN = false;
    bf16 *QA, *KA, *QB, *KB, *VBT, *GA, *GB; const float* bias; const float* cs;
    __device__ __forceinline__ void operator()(const f32x4 (&acc)[2][2][4][2], const pg8::Unit& u, int wr, int wc, int fr, int fq) const {
        const int row0 = u.pm * 256 + wr * 64 + fr;
#pragma unroll
        for (int bj = 0; bj < 2; ++bj) {
            const int cb = u.pn * 256 + bj * 128;
            const int c = cb + wc * 32 + 8 * fq;
            const int src = c < 1024 ? c : c + 512;
            const f32x4 b0 = *(const f32x4*)(bias + src), b1 = *(const f32x4*)(bias + src + 4);
            int kind; bf16* dst; int ld, coff;
            if (cb < 512) { kind = 0; dst = QA; ld = 512; coff = c; }
            else if (cb < 1024) { kind = 1; dst = KA; ld = 512; coff = c - 512; }
            else if (cb < 1536) { kind = 2; dst = QB; ld = 512; coff = c - 1024; }
            else if (cb < 1664) { kind = 3; dst = KB; ld = 128; coff = c - 1536; }
            else if (cb < 1792) { kind = 4; dst = VBT; ld = 0; coff = c - 1664; }
            else if (cb < 2816) { kind = 5; dst = GA; ld = 1024; coff = c - 1792; }
            else { kind = 5; dst = GB; ld = 1024; coff = c - 2816; }
            const bool rot = (kind == 2 || kind == 3) && ((wc & 1) == 0);
#pragma unroll
            for (int ai = 0; ai < 2; ++ai)
#pragma unroll
                for (int m = 0; m < 4; ++m) {
                    const int row = row0 + ai * 128 + m * 16;
                    f32x4 v0 = acc[ai][bj][m][0] + b0, v1 = acc[ai][bj][m][1] + b1;
                    if (rot) {
                        const float* t = cs + (size_t)(row & (SEQ - 1)) * 16;
                        const f32x4 c0 = *(const f32x4*)t, c1 = *(const f32x4*)(t + 4), s0 = *(const f32x4*)(t + 8), s1 = *(const f32x4*)(t + 12);
                        f32x4 p0, p1;
#pragma unroll
                        for (int e = 0; e < 4; ++e) { p0[e] = __shfl_xor(v0[e], 16); p1[e] = __shfl_xor(v1[e], 16); }
                        const float sg = (fq == 0) ? -1.f : 1.f;
                        if (fq < 2) { v0 = v0 * c0 + (p0 * sg) * s0; v1 = v1 * c1 + (p1 * sg) * s1; }
                    }
                    if (kind == 0 || kind == 2) { v0 = v0 * 0.125f; v1 = v1 * 0.125f; }
                    if (kind == 5) {
#pragma unroll
                        for (int e = 0; e < 4; ++e) { v0[e] = 1.f / (1.f + __expf(-v0[e])); v1[e] = 1.f / (1.f + __expf(-v1[e])); }
                    }
                    if (kind == 4) {
#pragma unroll
                        for (int e = 0; e < 4; ++e) { dst[(size_t)(coff + e) * M + row] = (bf16)(pk2(v0[e], 0.f) & 0xffffu); dst[(size_t)(coff + 4 + e) * M + row] = (bf16)(pk2(v1[e], 0.f) & 0xffffu); }
                    } else {
                        v4u w; w.x = pk2(v0[0], v0[1]); w.y = pk2(v0[2], v0[3]); w.z = pk2(v1[0], v1[1]); w.w = pk2(v1[2], v1[3]);
                        *(v4u*)(dst + (size_t)row * ld + coff) = w;
                    }
                }
        }
    }
};
struct EpiVT {
    static constexpr bool PERM = true, AFTER_DRAIN = false;
    bf16* VAT; const float* bias;
    __device__ __forceinline__ void operator()(const f32x4 (&acc)[2][2][4][2], const pg8::Unit& u, int wr, int wc, int fr, int fq) const {
        const int row0 = u.pm * 256 + wr * 64 + fr, col0 = u.pn * 256 + wc * 32 + 8 * fq;
#pragma unroll
        for (int ai = 0; ai < 2; ++ai)
#pragma unroll
            for (int m = 0; m < 4; ++m) { const int row = row0 + ai * 128 + m * 16; const float b = bias[row];
#pragma unroll
                for (int bj = 0; bj < 2; ++bj) { const f32x4 v0 = acc[ai][bj][m][0] + b, v1 = acc[ai][bj][m][1] + b;
                    v4u w; w.x = pk2(v0[0], v0[1]); w.y = pk2(v0[2], v0[3]); w.z = pk2(v1[0], v1[1]); w.w = pk2(v1[2], v1[3]);
                    *(v4u*)(VAT + (size_t)row * M + col0 + bj * 128) = w; } }
    }
};
template <int MODE> struct EpiGate {
    static constexpr bool PERM = true, AFTER_DRAIN = false;
    bf16* T; const bf16* G;
    __device__ __forceinline__ void operator()(const f32x4 (&acc)[2][2][4][2], const pg8::Unit& u, int wr, int wc, int fr, int fq) const {
        const int row0 = u.pm * 256 + wr * 64 + fr, col0 = u.pn * 256 + wc * 32 + 8 * fq;
#pragma unroll
        for (int ai = 0; ai < 2; ++ai)
#pragma unroll
            for (int m = 0; m < 4; ++m)
#pragma unroll
                for (int bj = 0; bj < 2; ++bj) {
                    const size_t off = (size_t)(row0 + ai * 128 + m * 16) * D + col0 + bj * 128;
                    const v4u gw = *(const v4u*)(G + off);
                    float r[8];
                    const f32x4 a0 = acc[ai][bj][m][0], a1 = acc[ai][bj][m][1];
                    r[0] = bf2f(gw.x & 0xffffu) * a0[0]; r[1] = bf2f(gw.x >> 16) * a0[1]; r[2] = bf2f(gw.y & 0xffffu) * a0[2]; r[3] = bf2f(gw.y >> 16) * a0[3];
                    r[4] = bf2f(gw.z & 0xffffu) * a1[0]; r[5] = bf2f(gw.z >> 16) * a1[1]; r[6] = bf2f(gw.w & 0xffffu) * a1[2]; r[7] = bf2f(gw.w >> 16) * a1[3];
                    if (MODE == 1) { const v4u tw = *(const v4u*)(T + off);
                        r[0] += bf2f(tw.x & 0xffffu); r[1] += bf2f(tw.x >> 16); r[2] += bf2f(tw.y & 0xffffu); r[3] += bf2f(tw.y >> 16);
                        r[4] += bf2f(tw.z & 0xffffu); r[5] += bf2f(tw.z >> 16); r[6] += bf2f(tw.w & 0xffffu); r[7] += bf2f(tw.w >> 16); }
                    v4u w; w.x = pk2(r[0], r[1]); w.y = pk2(r[2], r[3]); w.z = pk2(r[4], r[5]); w.w = pk2(r[6], r[7]);
                    *(v4u*)(T + off) = w;
                }
    }
};
struct EpiZ1 {
    static constexpr bool PERM = false, AFTER_DRAIN = false;
    float* Z; const float* x; const float* stats; const float* g0; const float* b0; const float* bias;
    __device__ __forceinline__ void operator()(const f32x4 (&acc)[2][2][4][2], const pg8::Unit& u, int wr, int wc, int fr, int fq) const {
        const int row0 = u.pm * 256 + wr * 64 + fr, col0 = u.pn * 256 + wc * 32 + 4 * fq;
#pragma unroll
        for (int ai = 0; ai < 2; ++ai)
#pragma unroll
            for (int m = 0; m < 4; ++m) { const int row = row0 + ai * 128 + m * 16; const float mean = stats[2 * row], rstd = stats[2 * row + 1];
#pragma unroll
                for (int bj = 0; bj < 2; ++bj)
#pragma unroll
                    for (int n = 0; n < 2; ++n) { const int col = col0 + bj * 128 + n * 16; const size_t off = (size_t)row * D + col;
                        const f32x4 xv = *(const f32x4*)(x + off), gv = *(const f32x4*)(g0 + col), bv = *(const f32x4*)(b0 + col), bb = *(const f32x4*)(bias + col);
                        const f32x4 h0 = (xv - mean) * rstd * gv + bv;
                        *(f32x4*)(Z + off) = acc[ai][bj][m][n] + bb + h0 * ALPHA; } }
    }
};
struct EpiFf1 {
    static constexpr bool PERM = true, AFTER_DRAIN = false;
    bf16* U; const float* bias;
    __device__ __forceinline__ void operator()(const f32x4 (&acc)[2][2][4][2], const pg8::Unit& u, int wr, int wc, int fr, int fq) const {
        const int row0 = u.pm * 256 + wr * 64 + fr, col0 = u.pn * 256 + wc * 32 + 8 * fq;
#pragma unroll
        for (int bj = 0; bj < 2; ++bj) { const f32x4 b0 = *(const f32x4*)(bias + col0 + bj * 128), b1 = *(const f32x4*)(bias + col0 + bj * 128 + 4);
#pragma unroll
            for (int ai = 0; ai < 2; ++ai)
#pragma unroll
                for (int m = 0; m < 4; ++m) { f32x4 v0 = acc[ai][bj][m][0] + b0, v1 = acc[ai][bj][m][1] + b1;
#pragma unroll
                    for (int e = 0; e < 4; ++e) { const float a = fmaxf(v0[e], 0.f), b = fmaxf(v1[e], 0.f); v0[e] = a * a; v1[e] = b * b; }
                    v4u w; w.x = pk2(v0[0], v0[1]); w.y = pk2(v0[2], v0[3]); w.z = pk2(v1[0], v1[1]); w.w = pk2(v1[2], v1[3]);
                    *(v4u*)(U + (size_t)(row0 + ai * 128 + m * 16) * FF + col0 + bj * 128) = w; } }
    }
};
struct EpiZ2 {
    static constexpr bool PERM = false, AFTER_DRAIN = false;
    float* Z; const float* bias;
    __device__ __forceinline__ void operator()(const f32x4 (&acc)[2][2][4][2], const pg8::Unit& u, int wr, int wc, int fr, int fq) const {
        const int row0 = u.pm * 256 + wr * 64 + fr, col0 = u.pn * 256 + wc * 32 + 4 * fq;
#pragma unroll
        for (int ai = 0; ai < 2; ++ai)
#pragma unroll
            for (int m = 0; m < 4; ++m) { const int row = row0 + ai * 128 + m * 16;
#pragma unroll
                for (int bj = 0; bj < 2; ++bj)
#pragma unroll
                    for (int n = 0; n < 2; ++n) { const int col = col0 + bj * 128 + n * 16; const size_t off = (size_t)row * D + col;
                        const f32x4 hv = *(const f32x4*)(Z + off), bb = *(const f32x4*)(bias + col);
                        *(f32x4*)(Z + off) = acc[ai][bj][m][n] + bb + hv * ALPHA; } }
    }
};

constexpr float L2E = 1.4426950408889634f;
__device__ __forceinline__ void na_unit(const bf16* QA, const bf16* KA, const bf16* VAT, bf16* O, const LAS float* rpb, int b, int h, int r, int cb, int lane) {
    const int n = lane & 15, rq = lane >> 4;
    const int rs = min(max(r - 4, 0), 120);
    const int kc0 = cb == 0 ? 0 : cb == 1 ? 8 : cb == 2 ? 24 : 32;
    const size_t tokb = (size_t)b * SEQ;
    const size_t qtok = tokb + r * 64 + cb * 16 + n;
    const bf16* qp = QA + qtok * 512 + h * 64 + rq * 8;
    const bf16x8 q0 = *(const bf16x8*)qp, q1 = *(const bf16x8*)(qp + 32);
    f32x4 s[16];
    const bf16* kbase = KA + (tokb + (size_t)rs * 64 + kc0 + n) * 512 + h * 64 + rq * 8;
#pragma unroll
    for (int jb = 0; jb < 16; ++jb) {
        const bf16* kp = kbase + (size_t)((jb >> 1) * 64 + (jb & 1) * 16) * 512;
        const bf16x8 k0 = *(const bf16x8*)kp, k1 = *(const bf16x8*)(kp + 32);
        f32x4 a = {0.f, 0.f, 0.f, 0.f};
        a = mfma16(k0, q0, a); a = mfma16(k1, q1, a); s[jb] = a;
    }
    const int c = 16 * cb + n, cs = min(max(c - 8, 0), 48);
    float mx = -1e30f;
#pragma unroll
    for (int jb = 0; jb < 16; ++jb) {
        const int kr = jb >> 1, half = jb & 1;
        const LAS float* rp = rpb + (h * 15 + (rs + kr - r) + 7) * 31;
#pragma unroll
        for (int e = 0; e < 4; ++e) {
            const int kc = kc0 + 16 * half + 4 * rq + e;
            const bool valid = (kc >= cs) && (kc < cs + 16);
            const int idx = min(max(kc - c + 15, 0), 30);
            const float v = valid ? s[jb][e] + rp[idx] : -1e30f;
            s[jb][e] = v; mx = fmaxf(mx, v);
        }
    }
    mx = fmaxf(mx, __shfl_xor(mx, 16)); mx = fmaxf(mx, __shfl_xor(mx, 32));
    float sum = 0.f;
#pragma unroll
    for (int jb = 0; jb < 16; ++jb)
#pragma unroll
        for (int e = 0; e < 4; ++e) { const float p = __builtin_amdgcn_exp2f((s[jb][e] - mx) * L2E); s[jb][e] = p; sum += p; }
    sum += __shfl_xor(sum, 16); sum += __shfl_xor(sum, 32);
    const float inv = 1.f / sum;
    f32x4 o[4];
#pragma unroll
    for (int dt = 0; dt < 4; ++dt) o[dt] = (f32x4){0.f, 0.f, 0.f, 0.f};
    const bf16* vbase = VAT + (size_t)(h * 64 + n) * M + tokb + (size_t)rs * 64 + kc0 + 4 * rq;
#pragma unroll
    for (int kr = 0; kr < 8; ++kr) {
        v4u pw; pw.x = pk2(s[2 * kr][0], s[2 * kr][1]); pw.y = pk2(s[2 * kr][2], s[2 * kr][3]); pw.z = pk2(s[2 * kr + 1][0], s[2 * kr + 1][1]); pw.w = pk2(s[2 * kr + 1][2], s[2 * kr + 1][3]);
        const bf16x8 pb = __builtin_bit_cast(bf16x8, pw);
#pragma unroll
        for (int dt = 0; dt < 4; ++dt) {
            const bf16* vp = vbase + (size_t)dt * 16 * M + kr * 64;
            const v2u lo = *(const v2u*)vp, hi = *(const v2u*)(vp + 16);
            v4u vw; vw.x = lo.x; vw.y = lo.y; vw.z = hi.x; vw.w = hi.y;
            o[dt] = mfma16(__builtin_bit_cast(bf16x8, vw), pb, o[dt]);
        }
    }
    bf16* op = O + qtok * 512 + h * 64 + 4 * rq;
#pragma unroll
    for (int dt = 0; dt < 4; ++dt) { v2u w; w.x = pk2(o[dt][0] * inv, o[dt][1] * inv); w.y = pk2(o[dt][2] * inv, o[dt][3] * inv); *(v2u*)(op + dt * 16) = w; }
}
__device__ __forceinline__ void swa_unit(const bf16* QB, const bf16* KB, const bf16* VBT, bf16* O, const float* sink, int b, int hq, int qb16, int lane) {
    const int n = lane & 15, rq = lane >> 4, g = hq >> 2, i0 = qb16 * 16;
    const size_t tokb = (size_t)b * SEQ;
    const size_t qtok = tokb + i0 + n;
    const bf16* qp = QB + qtok * 512 + hq * 64 + rq * 8;
    const bf16x8 q0 = *(const bf16x8*)qp, q1 = *(const bf16x8*)(qp + 32);
    f32x4 s[18];
#pragma unroll
    for (int jb = 0; jb < 18; ++jb) {
        const int kc = min(max(i0 - 128 + 16 * jb, 0), SEQ - 16);
        const bf16* kp = KB + (tokb + kc + n) * 128 + g * 64 + rq * 8;
        const bf16x8 k0 = *(const bf16x8*)kp, k1 = *(const bf16x8*)(kp + 32);
        f32x4 a = {0.f, 0.f, 0.f, 0.f};
        a = mfma16(k0, q0, a); a = mfma16(k1, q1, a); s[jb] = a;
    }
    const float sk = sink[hq];
    float mx = sk;
#pragma unroll
    for (int jb = 0; jb < 18; ++jb)
#pragma unroll
        for (int e = 0; e < 4; ++e) {
            const int kpos = i0 - 128 + 16 * jb + 4 * rq + e, rel = kpos - (i0 + n);
            const bool valid = (kpos >= 0) && (kpos < SEQ) && (rel >= -128) && (rel <= 128);
            const float v = valid ? s[jb][e] : -1e30f;
            s[jb][e] = v; mx = fmaxf(mx, v);
        }
    mx = fmaxf(mx, __shfl_xor(mx, 16)); mx = fmaxf(mx, __shfl_xor(mx, 32));
    float sum = 0.f;
#pragma unroll
    for (int jb = 0; jb < 18; ++jb)
#pragma unroll
        for (int e = 0; e < 4; ++e) { const float p = __builtin_amdgcn_exp2f((s[jb][e] - mx) * L2E); s[jb][e] = p; sum += p; }
    sum += __shfl_xor(sum, 16); sum += __shfl_xor(sum, 32);
    sum += __builtin_amdgcn_exp2f((sk - mx) * L2E);
    const float inv = 1.f / sum;
    f32x4 o[4];
#pragma unroll
    for (int dt = 0; dt < 4; ++dt) o[dt] = (f32x4){0.f, 0.f, 0.f, 0.f};
    const bf16* vbase = VBT + (size_t)(g * 64 + n) * M + tokb + 4 * rq;
#pragma unroll
    for (int ks = 0; ks < 9; ++ks) {
        v4u pw; pw.x = pk2(s[2 * ks][0], s[2 * ks][1]); pw.y = pk2(s[2 * ks][2], s[2 * ks][3]); pw.z = pk2(s[2 * ks + 1][0], s[2 * ks + 1][1]); pw.w = pk2(s[2 * ks + 1][2], s[2 * ks + 1][3]);
        const bf16x8 pb = __builtin_bit_cast(bf16x8, pw);
        const int kc0 = min(max(i0 - 128 + 32 * ks, 0), SEQ - 16), kc1 = min(max(i0 - 128 + 32 * ks + 16, 0), SEQ - 16);
#pragma unroll
        for (int dt = 0; dt < 4; ++dt) {
            const bf16* vp = vbase + (size_t)dt * 16 * M;
            const v2u lo = *(const v2u*)(vp + kc0), hi = *(const v2u*)(vp + kc1);
            v4u vw; vw.x = lo.x; vw.y = lo.y; vw.z = hi.x; vw.w = hi.y;
            o[dt] = mfma16(__builtin_bit_cast(bf16x8, vw), pb, o[dt]);
        }
    }
    bf16* op = O + qtok * 512 + hq * 64 + 4 * rq;
#pragma unroll
    for (int dt = 0; dt < 4; ++dt) { v2u w; w.x = pk2(o[dt][0] * inv, o[dt][1] * inv); w.y = pk2(o[dt][2] * inv, o[dt][3] * inv); *(v2u*)(op + dt * 16) = w; }
}

__device__ __forceinline__ void load_row64(const bf16* p, float (&q)[64]) {
#pragma unroll
    for (int i = 0; i < 8; ++i) { const v4u w = *(const v4u*)(p + 8 * i);
        q[8 * i + 0] = bf2f(w.x & 0xffffu); q[8 * i + 1] = bf2f(w.x >> 16); q[8 * i + 2] = bf2f(w.y & 0xffffu); q[8 * i + 3] = bf2f(w.y >> 16);
        q[8 * i + 4] = bf2f(w.z & 0xffffu); q[8 * i + 5] = bf2f(w.z >> 16); q[8 * i + 6] = bf2f(w.w & 0xffffu); q[8 * i + 7] = bf2f(w.w >> 16); }
}
__device__ __forceinline__ float dot_row64(const bf16* p, const float (&q)[64]) {
    float s = 0.f;
#pragma unroll
    for (int i = 0; i < 8; ++i) { const v4u w = *(const v4u*)(p + 8 * i);
        s += q[8 * i + 0] * bf2f(w.x & 0xffffu) + q[8 * i + 1] * bf2f(w.x >> 16) + q[8 * i + 2] * bf2f(w.y & 0xffffu) + q[8 * i + 3] * bf2f(w.y >> 16)
           + q[8 * i + 4] * bf2f(w.z & 0xffffu) + q[8 * i + 5] * bf2f(w.z >> 16) + q[8 * i + 6] * bf2f(w.w & 0xffffu) + q[8 * i + 7] * bf2f(w.w >> 16); }
    return s;
}
__device__ __forceinline__ void store_row64(bf16* p, const float (&o)[64], float inv) {
#pragma unroll
    for (int i = 0; i < 8; ++i) { v4u w; w.x = pk2(o[8 * i] * inv, o[8 * i + 1] * inv); w.y = pk2(o[8 * i + 2] * inv, o[8 * i + 3] * inv); w.z = pk2(o[8 * i + 4] * inv, o[8 * i + 5] * inv); w.w = pk2(o[8 * i + 6] * inv, o[8 * i + 7] * inv);
        *(v4u*)(p + 8 * i) = w; }
}
__device__ __noinline__ void naive_attn(const bf16* QA, const bf16* KA, const bf16* VAT, const bf16* QB, const bf16* KB, const bf16* VBT, const float* rpb, const float* sink, int gtid, int nthreads) {
    for (int it = gtid; it < 2 * M * 8; it += nthreads) {
        const bool swa = it >= M * 8; const int u = swa ? it - M * 8 : it;
        const int tok = u & (M - 1), h = u >> 14;
        const int b = tok >> 13, t = tok & (SEQ - 1);
        float q[64], o[64];
#pragma unroll
        for (int d = 0; d < 64; ++d) o[d] = 0.f;
        float mx, l;
        if (!swa) {
            load_row64(QA + (size_t)tok * 512 + h * 64, q);
            const int r = t >> 6, c = t & 63, rs = min(max(r - 4, 0), 120), cs = min(max(c - 8, 0), 48);
            mx = -1e30f; l = 0.f;
            for (int kk = 0; kk < 128; ++kk) {
                const int kr = kk >> 4, j = kk & 15; const size_t kt = (size_t)b * SEQ + (rs + kr) * 64 + cs + j;
                const float sc = dot_row64(KA + kt * 512 + h * 64, q) + rpb[(h * 15 + (rs + kr - r) + 7) * 31 + (cs + j - c) + 15];
                const float mn = fmaxf(mx, sc), f = __expf(mx - mn), p = __expf(sc - mn);
                l = l * f + p; mx = mn;
#pragma unroll
                for (int d = 0; d < 64; ++d) o[d] = o[d] * f + p * bf2f(VAT[(size_t)(h * 64 + d) * M + kt]);
            }
            store_row64((bf16*)QA + (size_t)tok * 512 + h * 64, o, 1.f / l);
        } else {
            load_row64(QB + (size_t)tok * 512 + h * 64, q);
            const int g = h >> 2; mx = sink[h]; l = 1.f;
            const int j0 = max(t - 128, 0), j1 = min(t + 128, SEQ - 1);
            for (int j = j0; j <= j1; ++j) {
                const size_t kt = (size_t)b * SEQ + j;
                const float sc = dot_row64(KB + kt * 128 + g * 64, q);
                const float mn = fmaxf(mx, sc), f = __expf(mx - mn), p = __expf(sc - mn);
                l = l * f + p; mx = mn;
#pragma unroll
                for (int d = 0; d < 64; ++d) o[d] = o[d] * f + p * bf2f(VBT[(size_t)(g * 64 + d) * M + kt]);
            }
            store_row64((bf16*)QB + (size_t)tok * 512 + h * 64, o, 1.f / l);
        }
    }
}

struct Args { const float* in[19]; float* out; unsigned char* ws; int naive; int pad; };
enum { I_X = 0, I_LN0G, I_LN0B, I_WIN, I_BIN, I_RPB, I_SINK, I_WBNA, I_WBSWA, I_WOUT, I_BOUT, I_LN1G, I_LN1B, I_W1, I_B1, I_W2, I_B2, I_LN2G, I_LN2B };

__global__ void __launch_bounds__(NTHREADS, 2) fwd_kernel(Args a) {
    extern __shared__ __attribute__((aligned(16))) unsigned char lds_raw[];
    cg::grid_group grid = cg::this_grid();
    LAS unsigned char* lds = (LAS unsigned char*)lds_raw;
    const int tid = threadIdx.x, lane = tid & 63, wave = __builtin_amdgcn_readfirstlane(tid >> 6);
    const int G = gridDim.x, gw = blockIdx.x * NWAVES + wave, NGW = G * NWAVES;
    unsigned char* ws = a.ws;
    float* stats = (float*)(ws + WS_STATS); float* cs = (float*)(ws + WS_CS);
    bf16* Win_t = (bf16*)(ws + WS_WIN); bf16* Wbna_t = (bf16*)(ws + WS_WBNA); bf16* Wbswa_t = (bf16*)(ws + WS_WBSWA); bf16* Wout_t = (bf16*)(ws + WS_WOUT);
    bf16* W1_t = (bf16*)(ws + WS_W1); bf16* W2_t = (bf16*)(ws + WS_W2);
    bf16* XN = (bf16*)(ws + WS_XN); bf16* QA = (bf16*)(ws + WS_QA); bf16* QB = (bf16*)(ws + WS_QB); bf16* KA = (bf16*)(ws + WS_KA); bf16* VAT = (bf16*)(ws + WS_VAT);
    bf16* KB = (bf16*)(ws + WS_KB); bf16* VBT = (bf16*)(ws + WS_VBT); bf16* GA = (bf16*)(ws + WS_GA); bf16* GB = (bf16*)(ws + WS_GB); bf16* MIX = (bf16*)(ws + WS_MIX); bf16* U = (bf16*)(ws + WS_U);

    {
        LAS float* scr = (LAS float*)(lds + wave * 16384);
        constexpr int I_IN = (D / 64) * (NIN / 32), I_BR = (512 / 64) * (D / 32), I_O = (D / 64) * (D / 32), I_1 = (D / 64) * (FF / 32), I_2 = (FF / 64) * (D / 32);
        constexpr int NITEMS = I_IN + 2 * I_BR + I_O + I_1 + I_2;
        for (int it = gw; it < NITEMS; it += NGW) {
            int r = it;
            if (r < I_IN) { const int nblk = NIN / 32, kb = r / nblk, nb = r % nblk, n0 = nb * 32;
                const int drow = n0 < 1024 ? n0 : (n0 < 1536 ? NMAIN + (n0 - 1024) : n0 - 512);
                transpose_item(a.in[I_WIN], D, NIN, Win_t, kb * 64, n0, drow, scr, lane); continue; } r -= I_IN;
            if (r < I_BR) { const int nblk = D / 32; transpose_item(a.in[I_WBNA], 512, D, Wbna_t, (r / nblk) * 64, (r % nblk) * 32, (r % nblk) * 32, scr, lane); continue; } r -= I_BR;
            if (r < I_BR) { const int nblk = D / 32; transpose_item(a.in[I_WBSWA], 512, D, Wbswa_t, (r / nblk) * 64, (r % nblk) * 32, (r % nblk) * 32, scr, lane); continue; } r -= I_BR;
            if (r < I_O) { const int nblk = D / 32; transpose_item(a.in[I_WOUT], D, D, Wout_t, (r / nblk) * 64, (r % nblk) * 32, (r % nblk) * 32, scr, lane); continue; } r -= I_O;
            if (r < I_1) { const int nblk = FF / 32; transpose_item(a.in[I_W1], D, FF, W1_t, (r / nblk) * 64, (r % nblk) * 32, (r % nblk) * 32, scr, lane); continue; } r -= I_1;
            { const int nblk = D / 32; transpose_item(a.in[I_W2], FF, D, W2_t, (r / nblk) * 64, (r % nblk) * 32, (r % nblk) * 32, scr, lane); }
        }
        for (int m = gw; m < M; m += NGW) ln_row<false, true, true>(a.in[I_X] + (size_t)m * D, a.in[I_LN0G], a.in[I_LN0B], nullptr, XN + (size_t)m * D, stats + 2 * m, lane);
        for (int i = blockIdx.x * NTHREADS + tid; i < SEQ * 8; i += G * NTHREADS) {
            const int pos = i >> 3, j = i & 7;
            const float fr = j == 0 ? 1.0f : j == 1 ? 0.19392274f : j == 2 ? 0.03760603f : j == 3 ? 0.0072926646f : j == 4 ? 0.0014142136f : j == 5 ? 0.0002742482f : j == 6 ? 5.3182957e-05f : 1.0313385e-05f;
            const float ang = (float)pos * fr;
            double rv = (double)ang * 0.15915494309189535; rv -= __builtin_rint(rv);
            cs[pos * 16 + j] = __builtin_amdgcn_cosf((float)rv); cs[pos * 16 + 8 + j] = __builtin_amdgcn_sinf((float)rv);
        }
    }
    grid.sync();
    {
        pg8::Gemm g{XN, Win_t, M, NMAIN, D}; pg8::StaticOrder S; S.init(M, NMAIN, G, (int)blockIdx.x);
        EpiProj E{QA, KA, QB, KB, VBT, GA, GB, a.in[I_BIN], cs};
        pg8::gemm_phase<EpiProj, pg8::StaticOrder, PG8_ALIGN, PG8_SP2>(lds, g, S, E);
        pg8::Gemm g2{Win_t + (size_t)NMAIN * D, XN, NVA, M, D}; pg8::StaticOrder S2; S2.init(NVA, M, G, (int)((blockIdx.x + 64) % G));
        EpiVT E2{VAT, a.in[I_BIN] + 1024};
        pg8::gemm_phase<EpiVT, pg8::StaticOrder, PG8_ALIGN, PG8_SP2>(lds, g2, S2, E2);
    }
    grid.sync();
    if (false) {
        naive_attn(QA, KA, VAT, QB, KB, VBT, a.in[I_RPB], a.in[I_SINK], blockIdx.x * NTHREADS + tid, G * NTHREADS);
    } else {
        LAS float* rpb = (LAS float*)lds;
        for (int i = tid; i < 8 * 15 * 31; i += NTHREADS) rpb[i] = a.in[I_RPB][i];
        __syncthreads();
        for (int u = gw; u < 8192; u += NGW) na_unit(QA, KA, VAT, QA, rpb, u >> 12, (u >> 9) & 7, (u >> 2) & 127, u & 3, lane);
        for (int u = gw; u < 8192; u += NGW) swa_unit(QB, KB, VBT, QB, a.in[I_SINK], u >> 12, ((u >> 11) & 1) * 4 + (u & 3), (u >> 2) & 511, lane);
    }
    grid.sync();
    {
        pg8::StaticOrder S; S.init(M, D, G, (int)blockIdx.x);
        pg8::Gemm g1{QA, Wbna_t, M, D, 512}; EpiGate<0> E1{MIX, GA};
        pg8::gemm_phase<EpiGate<0>, pg8::StaticOrder, PG8_ALIGN, PG8_SP2>(lds, g1, S, E1);
        pg8::Gemm g2{QB, Wbswa_t, M, D, 512}; EpiGate<1> E2{MIX, GB};
        pg8::gemm_phase<EpiGate<1>, pg8::StaticOrder, PG8_ALIGN, PG8_SP2>(lds, g2, S, E2);
    }
    grid.sync();
    {
        pg8::StaticOrder S; S.init(M, D, G, (int)blockIdx.x);
        pg8::Gemm g{MIX, Wout_t, M, D, D}; EpiZ1 E{a.out, a.in[I_X], stats, a.in[I_LN0G], a.in[I_LN0B], a.in[I_BOUT]};
        pg8::gemm_phase<EpiZ1, pg8::StaticOrder, PG8_ALIGN, PG8_SP2>(lds, g, S, E);
    }
    grid.sync();
    for (int m = gw; m < M; m += NGW) ln_row<true, true, false>(a.out + (size_t)m * D, a.in[I_LN1G], a.in[I_LN1B], a.out + (size_t)m * D, XN + (size_t)m * D, nullptr, lane);
    grid.sync();
    {
        pg8::StaticOrder S; S.init(M, FF, G, (int)blockIdx.x);
        pg8::Gemm g{XN, W1_t, M, FF, D}; EpiFf1 E{U, a.in[I_B1]};
        pg8::gemm_phase<EpiFf1, pg8::StaticOrder, PG8_ALIGN, PG8_SP2>(lds, g, S, E);
    }
    grid.sync();
    {
        pg8::StaticOrder S; S.init(M, D, G, (int)blockIdx.x);
        pg8::Gemm g{U, W2_t, M, D, FF}; EpiZ2 E{a.out, a.in[I_B2]};
        pg8::gemm_phase<EpiZ2, pg8::StaticOrder, PG8_ALIGN, PG8_SP2>(lds, g, S, E);
    }
    grid.sync();
    for (int m = gw; m < M; m += NGW) ln_row<true, false, false>(a.out + (size_t)m * D, a.in[I_LN2G], a.in[I_LN2B], a.out + (size_t)m * D, nullptr, nullptr, lane);
}

#ifndef NAIVE_ATTN
#define NAIVE_ATTN 0
#endif
extern "C" void kernel_launch(void* const* d_in, const int* in_sizes, int n_in, void* d_out, int out_size, void* d_ws, size_t ws_size, hipStream_t stream) {
    static int grid = 0;
    if (grid == 0) {
        if (n_in != 19 || in_sizes[0] != M * D || out_size != M * D || ws_size < WS_END) { fprintf(stderr, "kernel_launch: unexpected shapes (n_in %d, in0 %d, out %d, ws %zu)\n", n_in, n_in > 0 ? in_sizes[0] : -1, out_size, ws_size); grid = -1; return; }
        int dev = 0, cus = 0, per_cu = 0;
        (void)hipGetDevice(&dev); (void)hipDeviceGetAttribute(&cus, hipDeviceAttributeMultiprocessorCount, dev);
        (void)hipFuncSetAttribute((const void*)fwd_kernel, hipFuncAttributeMaxDynamicSharedMemorySize, LDS_BYTES);
        (void)hipOccupancyMaxActiveBlocksPerMultiprocessor(&per_cu, (const void*)fwd_kernel, NTHREADS, LDS_BYTES);
        if (per_cu < 1) per_cu = 1;
        grid = cus * per_cu;
        (void)hipGetLastError();
    }
    if (grid < 0) return;
    Args a{};
    for (int i = 0; i < 19; ++i) a.in[i] = (const float*)d_in[i];
    a.out = (float*)d_out; a.ws = (unsigned char*)d_ws; a.naive = NAIVE_ATTN; a.pad = 0;
    void* params[] = {&a};
    hipError_t e = hipLaunchCooperativeKernel((const void*)fwd_kernel, dim3(grid), dim3(NTHREADS), params, LDS_BYTES, stream);
    if (e != hipSuccess) fprintf(stderr, "cooperative launch failed: %s (grid %d)\n", hipGetErrorString(e), grid);
}
```

```cpp
#include <hip/hip_runtime.h>
#include <cstdio>
#include <cstdint>
namespace pg8 {
#define PG8_LAS __attribute__((address_space(3)))
typedef unsigned short bf16_t;
typedef short bf16x8 __attribute__((ext_vector_type(8)));
typedef float f32x4 __attribute__((ext_vector_type(4)));
typedef unsigned u32x4 __attribute__((ext_vector_type(4)));
constexpr int BM = 256, BK = 64, HALF = 128, HTB = HALF * BK * 2  , STAGE_BYTES = 8 * HTB, NXCD = 8, WGM = 8;

__host__ __device__ __forceinline__ int lds_byte(int r, int c) { const int st = (r >> 4) * 2 + (c >> 5), rr = r & 15, cc = c & 31, ob = rr * 64 + cc * 2; return st * 1024 + (ob ^ (((ob >> 9) & 1) << 5)); }
__host__ __device__ __forceinline__ void stage_rc(int b, int& R, int& C) { const int st = b / 1024, sb = b % 1024, swz = sb ^ (((sb >> 9) & 1) << 5); R = (st >> 1) * 16 + swz / 64; C = (st & 1) * 32 + (swz % 64) / 2; }
__host__ __device__ __forceinline__ int perm32(int rho) { const int n = rho >> 4, i = rho & 15; return 8 * (i >> 2) + 4 * n + (i & 3); }

struct Unit { int pm, pn; };
struct Gemm { const bf16_t* A; const bf16_t* Bt; int M, N, K; };

struct StaticOrder {
    int nM, nN, nwg, G, c;
    __host__ __device__ void init(int M, int N, int G_, int c_) { nM = M / BM; nN = N / BM; nwg = nM * nN; G = G_; c = c_; }
    __host__ __device__ bool next(int i, Unit& u) const {
        const long L = (long)i * G + c; if (L >= nwg) return false;
        int wgid = (int)L; { const int q = nwg / NXCD, r = nwg % NXCD, xcd = wgid % NXCD, off = wgid / NXCD; wgid = (xcd < r ? xcd * (q + 1) : r * (q + 1) + (xcd - r) * q) + off; }
        const int nig = WGM * nN, gid = wgid / nig, fm = gid * WGM, gsz = (nM - fm) < WGM ? (nM - fm) : WGM;
        u.pm = fm + ((wgid % nig) % gsz); u.pn = (wgid % nig) / gsz; return true;
    }
    __device__ __forceinline__ void a_ready(const Unit&) const {}
    __device__ __forceinline__ void done(const Unit&) const {}
};

__device__ __forceinline__ unsigned cvt_pk_bf16(float lo, float hi) { unsigned r; asm volatile("v_cvt_pk_bf16_f32 %0, %1, %2" : "=v"(r) : "v"(lo), "v"(hi)); return r; }
typedef float f32x2 __attribute__((ext_vector_type(2)));
__device__ __forceinline__ f32x2 gelu_pk(f32x2 v) {
    const f32x2 av = __builtin_elementwise_abs(v), d = av * 0.2316418882f + 1.0f;
    f32x2 t; t.x = __builtin_amdgcn_rcpf(d.x); t.y = __builtin_amdgcn_rcpf(d.y);
    f32x2 q = t * 0.5307027145f + (-0.7265760135f); q = q * t + 0.7107068705f; q = q * t + (-0.142248368f); q = q * t + 0.127414796f; q = q * t;
    const f32x2 s = (v * v) * (-0.72134752044f);
    f32x2 e; e.x = __builtin_amdgcn_exp2f(s.x); e.y = __builtin_amdgcn_exp2f(s.y);
    const f32x2 m = v * (q * e), r = v - m;
    f32x2 o; o.x = v.x < 0.f ? m.x : r.x; o.y = v.y < 0.f ? m.y : r.y; return o;
}

template <int ACT  > struct EpiBf16 {
    static constexpr bool PERM = true, AFTER_DRAIN = false; static_assert(ACT == 0 || ACT == 1, "EpiBf16: ACT is 0 (none) or 1 (gelu_pk)");
    bf16_t* O; int ldc; const float* bias; int split_cols; size_t split_stride; float scale0;
    __device__ __forceinline__ void operator()(const f32x4 (&acc)[2][2][4][2], const Unit& u, int wr, int wc, int fr, int fq) const {
        const int row0 = u.pm * BM + wr * 64 + fr; int colt = u.pn * BM; bf16_t* base = O;
        float sc = 1.f; if (split_cols) { const int t = colt / split_cols; base += (size_t)t * split_stride; colt -= t * split_cols; if (t == 0) sc = scale0; }
        const int col0 = colt + wc * 32 + 8 * fq, bcol0 = u.pn * BM + wc * 32 + 8 * fq;
        f32x4 bv[2][2];
#pragma unroll
        for (int bj = 0; bj < 2; ++bj)
#pragma unroll
            for (int n = 0; n < 2; ++n) bv[bj][n] = bias ? *(const f32x4*)(bias + bcol0 + bj * HALF + 4 * n) : (f32x4){0.f, 0.f, 0.f, 0.f};
#pragma unroll
        for (int ai = 0; ai < 2; ++ai)
#pragma unroll
            for (int m = 0; m < 4; ++m) { bf16_t* rowp = base + (size_t)(row0 + ai * HALF + m * 16) * ldc + col0;
#pragma unroll
                for (int bj = 0; bj < 2; ++bj) { f32x4 v0 = acc[ai][bj][m][0] + bv[bj][0], v1 = acc[ai][bj][m][1] + bv[bj][1];
                    if (ACT == 1) { f32x2 a = gelu_pk((f32x2){v0[0], v0[1]}), b = gelu_pk((f32x2){v0[2], v0[3]}), c = gelu_pk((f32x2){v1[0], v1[1]}), d = gelu_pk((f32x2){v1[2], v1[3]});
                        v0 = (f32x4){a.x, a.y, b.x, b.y}; v1 = (f32x4){c.x, c.y, d.x, d.y}; }
                    v0 = v0 * sc; v1 = v1 * sc; u32x4 w; w.x = cvt_pk_bf16(v0[0], v0[1]); w.y = cvt_pk_bf16(v0[2], v0[3]); w.z = cvt_pk_bf16(v1[0], v1[1]); w.w = cvt_pk_bf16(v1[2], v1[3]);
                    *(u32x4*)(rowp + bj * HALF) = w; } }
    }
};

struct PanelStats {
    unsigned* xbuf;
    unsigned* cnt;
    unsigned* tmo;
    int ntn; float eps;
    unsigned code;
    __device__ __forceinline__ bool run(const f32x4 (&v)[2][2][4][2], const Unit& u, int wr, int wc, int fr, int fq, PG8_LAS unsigned char* lds, int wid, int lane) const {
        typedef float f32x2v __attribute__((ext_vector_type(2)));
        PG8_LAS f32x2v* P = (PG8_LAS f32x2v*)lds;
        PG8_LAS f32x2v* S = (PG8_LAS f32x2v*)(lds + 8192);
        PG8_LAS unsigned* flag = (PG8_LAS unsigned*)(lds + 8192 + 2048);
#pragma unroll
        for (int ai = 0; ai < 2; ++ai)
#pragma unroll
            for (int m = 0; m < 4; ++m) {
                float s = 0.f;
#pragma unroll
                for (int bj = 0; bj < 2; ++bj)
#pragma unroll
                    for (int n = 0; n < 2; ++n) { const f32x4 x = v[ai][bj][m][n]; s += (x[0] + x[1]) + (x[2] + x[3]); }
                s += __shfl_xor(s, 16); s += __shfl_xor(s, 32);
                const float mw = s * (1.0f / 64.0f); float q = 0.f;
#pragma unroll
                for (int bj = 0; bj < 2; ++bj)
#pragma unroll
                    for (int n = 0; n < 2; ++n) { const f32x4 d = v[ai][bj][m][n] - mw; q += (d[0] * d[0] + d[1] * d[1]) + (d[2] * d[2] + d[3] * d[3]); }
                q += __shfl_xor(q, 16); q += __shfl_xor(q, 32);
                if (fq == 0) P[(ai * HALF + wr * 64 + m * 16 + fr) * 4 + wc] = (f32x2v){mw, q};
            }
        asm volatile("s_waitcnt lgkmcnt(0)" ::: "memory"); __builtin_amdgcn_s_barrier(); asm volatile("" ::: "memory");
#if defined(BROKEN_EXCHANGE_NO_WAIT)
#warning BROKEN CONTROL BUILD: the row-statistics exchange does not wait; results are wrong by design
        if (blockIdx.x >= 64) { const long long t0_ = clock64(); while (clock64() - t0_ < 60000) __builtin_amdgcn_s_sleep(8); }
#endif
        const int row = wid * 32 + (lane & 31);
        if (lane < 32) {
            const f32x2v a = P[row * 4 + 0], b = P[row * 4 + 1], c = P[row * 4 + 2], d = P[row * 4 + 3];
            const float mt = (a.x + b.x + c.x + d.x) * 0.25f;
            const float da = a.x - mt, db = b.x - mt, dc = c.x - mt, dd = d.x - mt;
            const float m2 = (a.y + b.y) + (c.y + d.y) + 64.0f * ((da * da + db * db) + (dc * dc + dd * dd));
            unsigned long long* slot = (unsigned long long*)xbuf + ((size_t)(u.pm * BM + row) * 4 + u.pn);
            __hip_atomic_store(slot, ((unsigned long long)__float_as_uint(m2) << 32) | __float_as_uint(mt), __ATOMIC_RELAXED, __HIP_MEMORY_SCOPE_AGENT);
        }
        asm volatile("s_waitcnt vmcnt(0)" ::: "memory");
        if (lane == 0) __hip_atomic_fetch_add(cnt + 64 * u.pm, 1u, __ATOMIC_RELAXED, __HIP_MEMORY_SCOPE_AGENT);
        if (wid == 0) {
            bool dead = false; const unsigned long long t0 = __builtin_amdgcn_s_memrealtime(); const unsigned want = 8u * (unsigned)ntn;
            for (;;) {
#if defined(BROKEN_EXCHANGE_NO_WAIT)
                break;
#endif
                if ((unsigned)__builtin_amdgcn_readfirstlane(__hip_atomic_load(cnt + 64 * u.pm, __ATOMIC_RELAXED, __HIP_MEMORY_SCOPE_AGENT)) >= want) break;
                if (__builtin_amdgcn_s_memrealtime() - t0 > 2000000ull) {
                    if (lane == 0) { unsigned expect = 0u; __hip_atomic_compare_exchange_strong(tmo + 1, &expect, code | (unsigned)(u.pm & 0xff), __ATOMIC_RELAXED, __ATOMIC_RELAXED, __HIP_MEMORY_SCOPE_AGENT);
                                     __hip_atomic_store(tmo, 1u, __ATOMIC_RELAXED, __HIP_MEMORY_SCOPE_AGENT); }
                    dead = true; break; }
                __builtin_amdgcn_s_sleep(2);
            }
            __builtin_amdgcn_fence(__ATOMIC_ACQUIRE, "agent");
            if (lane == 0) flag[0] = dead ? 1u : 0u;
        }
        asm volatile("s_waitcnt vmcnt(0) lgkmcnt(0)" ::: "memory"); __builtin_amdgcn_s_barrier(); asm volatile("" ::: "memory");
        const bool bad = flag[0] != 0u;
        if (lane < 32) {
            const unsigned long long* slot = (const unsigned long long*)xbuf + (size_t)(u.pm * BM + row) * 4; float mt[4], m2[4]; float ms = 0.f;
#pragma unroll
            for (int t = 0; t < 4; ++t) { if (t < ntn) { const unsigned long long w = __hip_atomic_load(slot + t, __ATOMIC_RELAXED, __HIP_MEMORY_SCOPE_AGENT); mt[t] = __uint_as_float((unsigned)w); m2[t] = __uint_as_float((unsigned)(w >> 32)); } else { mt[t] = 0.f; m2[t] = 0.f; } ms += mt[t]; }
            const float mean = ms / (float)ntn; float q = 0.f;
#pragma unroll
            for (int t = 0; t < 4; ++t) if (t < ntn) { const float dm = mt[t] - mean; q += m2[t] + 256.0f * dm * dm; }
            S[row] = (f32x2v){mean, 1.0f / sqrtf(q / (256.0f * (float)ntn) + eps)};
        }
        asm volatile("s_waitcnt lgkmcnt(0)" ::: "memory"); __builtin_amdgcn_s_barrier(); asm volatile("" ::: "memory");
        return bad;
    }
};
struct EpiLnRes {
    static constexpr bool PERM = false, AFTER_DRAIN = true;
    const float* base; float* out; int ldc; const float* bias; PanelStats st; unsigned poison;
    __device__ __forceinline__ void fused(f32x4 (&acc)[2][2][4][2], const Unit& u, int wr, int wc, int fr, int fq, PG8_LAS unsigned char* lds, int wid, int lane) const {
        typedef float f32x2v __attribute__((ext_vector_type(2)));
        const PG8_LAS f32x2v* S = (const PG8_LAS f32x2v*)(lds + 8192);
        const int col0 = u.pn * BM + wc * 32 + 4 * fq;
#pragma unroll
        for (int bj = 0; bj < 2; ++bj)
#pragma unroll
            for (int n = 0; n < 2; ++n) { const f32x4 bv = bias ? *(const f32x4*)(bias + col0 + bj * HALF + n * 16) : (f32x4){0.f, 0.f, 0.f, 0.f};
#pragma unroll
                for (int ai = 0; ai < 2; ++ai)
#pragma unroll
                    for (int m = 0; m < 4; ++m) acc[ai][bj][m][n] += bv; }
        f32x4 pre[4][2][2];
#pragma unroll
        for (int m = 0; m < 4; ++m) { const size_t off = (size_t)(u.pm * BM + wr * 64 + m * 16 + fr) * ldc + col0;
#pragma unroll
            for (int bj = 0; bj < 2; ++bj)
#pragma unroll
                for (int n = 0; n < 2; ++n) pre[m][bj][n] = *(const f32x4*)(base + off + bj * HALF + n * 16); }
        const bool bad = st.run(acc, u, wr, wc, fr, fq, lds, wid, lane) || poison != 0u;
        const float qnan = __builtin_nanf("");
#pragma unroll
        for (int ai = 0; ai < 2; ++ai)
#pragma unroll
            for (int m = 0; m < 4; ++m) { const int r = ai * HALF + wr * 64 + m * 16 + fr; const f32x2v sr = S[r]; const size_t off = (size_t)(u.pm * BM + r) * ldc + col0;
#pragma unroll
                for (int bj = 0; bj < 2; ++bj)
#pragma unroll
                    for (int n = 0; n < 2; ++n) { const f32x4 bs = ai == 0 ? pre[m][bj][n] : *(const f32x4*)(base + off + bj * HALF + n * 16); f32x4 o = bs + (acc[ai][bj][m][n] - sr.x) * sr.y;
                        if (bad) o = (f32x4){qnan, qnan, qnan, qnan}; *(f32x4*)(out + off + bj * HALF + n * 16) = o; }
                if (m & 1) asm volatile("" ::: "memory"); }
    }
};
struct EpiLnResLn {
    static constexpr bool PERM = false, AFTER_DRAIN = true;
    const float* base; float* out; bf16_t* xn; int ldc; const float* bias; PanelStats st1, st2; unsigned poison;
    __device__ __forceinline__ void fused(f32x4 (&acc)[2][2][4][2], const Unit& u, int wr, int wc, int fr, int fq, PG8_LAS unsigned char* lds, int wid, int lane) const {
        typedef float f32x2v __attribute__((ext_vector_type(2))); typedef unsigned u32x2v __attribute__((ext_vector_type(2)));
        const PG8_LAS f32x2v* S = (const PG8_LAS f32x2v*)(lds + 8192);
        const int col0 = u.pn * BM + wc * 32 + 4 * fq;
#pragma unroll
        for (int bj = 0; bj < 2; ++bj)
#pragma unroll
            for (int n = 0; n < 2; ++n) { const f32x4 bv = bias ? *(const f32x4*)(bias + col0 + bj * HALF + n * 16) : (f32x4){0.f, 0.f, 0.f, 0.f};
#pragma unroll
                for (int ai = 0; ai < 2; ++ai)
#pragma unroll
                    for (int m = 0; m < 4; ++m) acc[ai][bj][m][n] += bv; }
        bool bad = st1.run(acc, u, wr, wc, fr, fq, lds, wid, lane) || poison != 0u;
        const float qnan = __builtin_nanf("");
#pragma unroll
        for (int ai = 0; ai < 2; ++ai)
#pragma unroll
            for (int m = 0; m < 4; ++m) { const int r = ai * HALF + wr * 64 + m * 16 + fr; const f32x2v sr = S[r]; const size_t off = (size_t)(u.pm * BM + r) * ldc + col0;
#pragma unroll
                for (int bj = 0; bj < 2; ++bj)
#pragma unroll
                    for (int n = 0; n < 2; ++n) { const f32x4 bs = *(const f32x4*)(base + off + bj * HALF + n * 16); acc[ai][bj][m][n] = bs + (acc[ai][bj][m][n] - sr.x) * sr.y; }
                asm volatile("" : "+v"(acc[ai][0][m][0]), "+v"(acc[ai][0][m][1]), "+v"(acc[ai][1][m][0]), "+v"(acc[ai][1][m][1]));
                if (m & 1) asm volatile("" ::: "memory"); }
        const bool bad1 = bad;
        bad = st2.run(acc, u, wr, wc, fr, fq, lds, wid, lane) || bad;
#pragma unroll
        for (int ai = 0; ai < 2; ++ai)
#pragma unroll
            for (int m = 0; m < 4; ++m) { const int r = ai * HALF + wr * 64 + m * 16 + fr; const f32x2v sr = S[r]; const size_t off = (size_t)(u.pm * BM + r) * ldc + col0;
#pragma unroll
                for (int bj = 0; bj < 2; ++bj)
#pragma unroll
                    for (int n = 0; n < 2; ++n) { const f32x4 x1 = acc[ai][bj][m][n]; *(f32x4*)(out + off + bj * HALF + n * 16) = bad1 ? (f32x4){qnan, qnan, qnan, qnan} : x1;
                        const f32x4 o = (x1 - sr.x) * sr.y; u32x2v w; w.x = cvt_pk_bf16(o[0], o[1]); w.y = cvt_pk_bf16(o[2], o[3]);
                        if (bad) { w.x = 0x7fc07fc0u; w.y = 0x7fc07fc0u; } *(u32x2v*)(xn + off + bj * HALF + n * 16) = w; }
                asm volatile("" ::: "memory"); }
    }
};

template <class Epi, class Sched, bool ALIGN_EPI = false, bool SP2 = false>
__device__ __forceinline__ void gemm_phase(PG8_LAS unsigned char* lds, const Gemm g, const Sched& S, const Epi& E) {
    const int tid = threadIdx.x, wid = __builtin_amdgcn_readfirstlane(tid >> 6), lane = tid & 63, wr = wid >> 2, wc = wid & 3, fr = lane & 15, fq = lane >> 4;
    const int K = g.K, nt = K / BK;
    unsigned voffA[2], voffB[2];
#pragma unroll
    for (int i = 0; i < 2; ++i) { int R, C; stage_rc(tid * 16 + i * 8192, R, C); const int Rb = Epi::PERM ? ((R & ~31) + perm32(R & 31)) : R;
        voffA[i] = (unsigned)(R * K + C) * 2u; voffB[i] = (unsigned)(Rb * K + C) * 2u; }
    const size_t kstep = (size_t)(BK * 2);
    const size_t hstep = (size_t)HALF * K * 2;
    const size_t tstep = 2 * hstep;
    const unsigned ldsw = (unsigned)wid * 1024u;
    const int aoff = lds_byte(wr * 64 + fr, fq * 8), boff = lds_byte(wc * 32 + fr, fq * 8);
#define PG8_SA(b, h) (((b) * 2 + (h)) * HTB)
#define PG8_SB(b, h) ((4 + (b) * 2 + (h)) * HTB)
#define PG8_STAGE(bufoff, gbase, voff) do { _Pragma("unroll") for (int _i = 0; _i < 2; ++_i) \
        __builtin_amdgcn_global_load_lds((const unsigned*)((const char*)(gbase) + (voff)[_i]), (PG8_LAS unsigned*)(lds + (bufoff) + ldsw + _i * 8192), 16, 0, 0); } while (0)
#define PG8_LDA(dst, b, h) do { _Pragma("unroll") for (int m = 0; m < 4; ++m) _Pragma("unroll") for (int k = 0; k < 2; ++k) dst[m][k] = *(const PG8_LAS bf16x8*)(lds + PG8_SA(b, h) + aoff + m * 2048 + k * 1024); } while (0)
#define PG8_LDB(dst, b, h) do { _Pragma("unroll") for (int n = 0; n < 2; ++n) _Pragma("unroll") for (int k = 0; k < 2; ++k) dst[n][k] = *(const PG8_LAS bf16x8*)(lds + PG8_SB(b, h) + boff + n * 2048 + k * 1024); } while (0)
#define PG8_MMA(ai, bj, At, Bt) do { __builtin_amdgcn_s_setprio(1); _Pragma("unroll") for (int m = 0; m < 4; ++m) _Pragma("unroll") for (int n = 0; n < 2; ++n) _Pragma("unroll") for (int k = 0; k < 2; ++k) \
        acc[ai][bj][m][n] = __builtin_amdgcn_mfma_f32_16x16x32_bf16(Bt[n][k], At[m][k], acc[ai][bj][m][n], 0, 0, 0); __builtin_amdgcn_s_setprio(0); } while (0)
#define PG8_WAIT_V(n) asm volatile("s_waitcnt vmcnt(" #n ")" ::: "memory")
#define PG8_WAIT_L(n) asm volatile("s_waitcnt lgkmcnt(" #n ")" ::: "memory")
#define PG8_BAR __builtin_amdgcn_s_barrier()
#define PG8_SCHED __builtin_amdgcn_sched_barrier(0)
    Unit cur, nxt; int ui = 0;
    if (!S.next(0, cur)) return;
    f32x4 acc[2][2][4][2];
#pragma unroll
    for (int a = 0; a < 2; ++a)
#pragma unroll
        for (int b = 0; b < 2; ++b)
#pragma unroll
            for (int m = 0; m < 4; ++m)
#pragma unroll
                for (int n = 0; n < 2; ++n) acc[a][b][m][n] = (f32x4){0.f, 0.f, 0.f, 0.f};
    bf16x8 At[4][2], B0[2][2], B1[2][2];
    const char* cA = (const char*)g.A + (size_t)cur.pm * tstep; const char* cB = (const char*)g.Bt + (size_t)cur.pn * tstep;
    S.a_ready(cur);
    if constexpr (SP2) {
        PG8_STAGE(PG8_SB(0, 0), cB, voffB); PG8_STAGE(PG8_SB(0, 1), cB + hstep, voffB); PG8_STAGE(PG8_SA(0, 0), cA, voffA); PG8_STAGE(PG8_SA(0, 1), cA + hstep, voffA);
        if (wr == 1) PG8_BAR;
        PG8_WAIT_V(2); PG8_BAR;
        PG8_STAGE(PG8_SB(1, 0), cB + kstep, voffB); PG8_STAGE(PG8_SA(1, 0), cA + kstep, voffA); PG8_STAGE(PG8_SB(1, 1), cB + hstep + kstep, voffB);
        PG8_WAIT_V(6); PG8_BAR;
    } else {
        PG8_STAGE(PG8_SB(0, 0), cB, voffB); PG8_STAGE(PG8_SA(0, 0), cA, voffA); PG8_STAGE(PG8_SB(0, 1), cB + hstep, voffB); PG8_STAGE(PG8_SA(0, 1), cA + hstep, voffA);
        if (wr == 1) PG8_BAR;
        PG8_WAIT_V(4); PG8_BAR;
        PG8_STAGE(PG8_SB(1, 0), cB + kstep, voffB); PG8_STAGE(PG8_SA(1, 0), cA + kstep, voffA); PG8_STAGE(PG8_SB(1, 1), cB + hstep + kstep, voffB);
        PG8_WAIT_V(6); PG8_BAR;
    }
    for (;;) {
        const bool has_next = S.next(ui + 1, nxt);
        const char* nA = has_next ? (const char*)g.A + (size_t)nxt.pm * tstep : cA; const char* nB = has_next ? (const char*)g.Bt + (size_t)nxt.pn * tstep : cB;
        for (int t = 0; t < nt; t += 2) {
            const bool last = (t == nt - 2);
            const char* a1 = cA + (size_t)(t + 1) * kstep;
            const char* a2 = last ? nA : cA + (size_t)(t + 2) * kstep; const char* b2 = last ? nB : cB + (size_t)(t + 2) * kstep;
            const char* a3 = a2 + kstep; const char* b3 = b2 + kstep;
            if (last && has_next) S.a_ready(nxt);
            if constexpr (SP2) {
            PG8_LDB(B0, 0, 0); PG8_LDB(B1, 0, 1); PG8_SCHED; PG8_LDA(At, 0, 0); PG8_STAGE(PG8_SA(1, 1), a1 + hstep, voffA);
            PG8_WAIT_V(8); PG8_WAIT_L(0); PG8_BAR; PG8_MMA(0, 0, At, B0); PG8_MMA(0, 1, At, B1); PG8_BAR; PG8_SCHED;
            PG8_LDA(At, 0, 1); PG8_STAGE(PG8_SB(0, 0), b2, voffB); PG8_STAGE(PG8_SB(0, 1), b2 + hstep, voffB); PG8_STAGE(PG8_SA(0, 0), a2, voffA);
            PG8_WAIT_V(8); PG8_WAIT_L(0); PG8_BAR; PG8_MMA(1, 0, At, B0); PG8_MMA(1, 1, At, B1); PG8_BAR; PG8_SCHED;
            PG8_LDB(B0, 1, 0); PG8_LDB(B1, 1, 1); PG8_SCHED; PG8_LDA(At, 1, 0); PG8_STAGE(PG8_SA(0, 1), a2 + hstep, voffA);
            PG8_WAIT_V(8); PG8_WAIT_L(0); PG8_BAR; PG8_MMA(0, 0, At, B0); PG8_MMA(0, 1, At, B1); PG8_BAR; PG8_SCHED;
            PG8_LDA(At, 1, 1); PG8_STAGE(PG8_SB(1, 0), b3, voffB); PG8_STAGE(PG8_SB(1, 1), b3 + hstep, voffB); PG8_STAGE(PG8_SA(1, 0), a3, voffA);
            PG8_WAIT_V(8); PG8_WAIT_L(0); PG8_BAR; PG8_MMA(1, 0, At, B0); PG8_MMA(1, 1, At, B1); PG8_BAR; PG8_SCHED;
            } else {
            PG8_LDB(B0, 0, 0); PG8_SCHED; PG8_LDA(At, 0, 0); PG8_STAGE(PG8_SA(1, 1), a1 + hstep, voffA);
            PG8_WAIT_L(8); PG8_BAR; PG8_WAIT_L(0); PG8_MMA(0, 0, At, B0); PG8_BAR; PG8_SCHED;
            PG8_LDB(B1, 0, 1); PG8_STAGE(PG8_SB(0, 0), b2, voffB);
            PG8_BAR; PG8_WAIT_L(0); PG8_MMA(0, 1, At, B1); PG8_BAR;
            PG8_LDA(At, 0, 1); PG8_STAGE(PG8_SA(0, 0), a2, voffA);
            PG8_BAR; PG8_WAIT_L(0); PG8_MMA(1, 0, At, B0); PG8_BAR; PG8_SCHED;
            PG8_STAGE(PG8_SB(0, 1), b2 + hstep, voffB);
            PG8_WAIT_V(6); PG8_BAR; PG8_MMA(1, 1, At, B1); PG8_BAR;
            PG8_LDB(B0, 1, 0); PG8_SCHED; PG8_LDA(At, 1, 0); PG8_STAGE(PG8_SA(0, 1), a2 + hstep, voffA);
            PG8_WAIT_L(8); PG8_BAR; PG8_WAIT_L(0); PG8_MMA(0, 0, At, B0); PG8_BAR; PG8_SCHED;
            PG8_LDB(B1, 1, 1); PG8_STAGE(PG8_SB(1, 0), b3, voffB);
            PG8_BAR; PG8_WAIT_L(0); PG8_MMA(0, 1, At, B1); PG8_BAR;
            PG8_LDA(At, 1, 1); PG8_STAGE(PG8_SA(1, 0), a3, voffA);
            PG8_BAR; PG8_WAIT_L(0); PG8_MMA(1, 0, At, B0); PG8_BAR; PG8_SCHED;
            PG8_STAGE(PG8_SB(1, 1), b3 + hstep, voffB);
            PG8_WAIT_V(6); PG8_BAR; PG8_MMA(1, 1, At, B1); PG8_BAR;
            }
        }
        if constexpr (ALIGN_EPI) { if (wr == 0) PG8_BAR; }
        if constexpr (!Epi::AFTER_DRAIN) { E(acc, cur, wr, wc, fr, fq); S.done(cur); }
        if (!has_next) break;
#pragma unroll
        for (int a = 0; a < 2; ++a)
#pragma unroll
            for (int b = 0; b < 2; ++b)
#pragma unroll
                for (int m = 0; m < 4; ++m)
#pragma unroll
                    for (int n = 0; n < 2; ++n) acc[a][b][m][n] = (f32x4){0.f, 0.f, 0.f, 0.f};
        cur = nxt; cA = nA; cB = nB; ++ui;
        if constexpr (ALIGN_EPI) { if (wr == 1) PG8_BAR; }
    }
    PG8_WAIT_V(0);
    if constexpr (!ALIGN_EPI) { if (wr == 0) PG8_BAR; }
    PG8_BAR;
    if constexpr (Epi::AFTER_DRAIN) { E.fused(acc, cur, wr, wc, fr, fq, lds, wid, lane); S.done(cur); }
#undef PG8_SA
#undef PG8_SB
#undef PG8_STAGE
#undef PG8_LDA
#undef PG8_LDB
#undef PG8_MMA
#undef PG8_WAIT_V
#undef PG8_WAIT_L
#undef PG8_BAR
#undef PG8_SCHED
}
}

#ifndef PG8_SP2
#define PG8_SP2 true
#endif
#ifndef PG8_ALIGN
#define PG8_ALIGN true
#endif
#include <hip/hip_cooperative_groups.h>
namespace cg = cooperative_groups;

#define LAS __attribute__((address_space(3)))
typedef unsigned short bf16;
typedef unsigned v4u __attribute__((ext_vector_type(4)));
typedef unsigned v2u __attribute__((ext_vector_type(2)));
typedef float f32x4 __attribute__((ext_vector_type(4)));
typedef short bf16x8 __attribute__((ext_vector_type(8)));

constexpr int NWAVES = 8, NTHREADS = 512;
constexpr int SEQ = 8192, M = 16384, D = 1024, FF = 4096, NMAIN = 3840, NVA = 512, NIN = 4352;
constexpr float LN_EPS = 1e-5f;
constexpr float ALPHA = 1.189207115002721f;
constexpr size_t MiB = 1u << 20;
constexpr size_t WS_STATS = 0, WS_CS = 256 * 1024;
constexpr size_t WS_WIN = 1 * MiB;
constexpr size_t WS_WBNA = 10 * MiB, WS_WBSWA = 11 * MiB, WS_WOUT = 12 * MiB, WS_W1 = 14 * MiB, WS_W2 = 22 * MiB;
constexpr size_t WS_XN = 32 * MiB;
constexpr size_t WS_QA = 64 * MiB, WS_QB = 80 * MiB, WS_KA = 96 * MiB, WS_VAT = 112 * MiB, WS_KB = 128 * MiB, WS_VBT = 132 * MiB, WS_GA = 136 * MiB, WS_GB = 168 * MiB;
constexpr size_t WS_MIX = 96 * MiB;
constexpr size_t WS_U = 64 * MiB;
constexpr size_t WS_ONA = 200 * MiB, WS_OSWA = 216 * MiB;
constexpr size_t WS_BAR = 240 * MiB, BAR_BYTES = 16384;
constexpr size_t WS_END = 241 * MiB;
constexpr int LDS_BYTES = 147456;

__device__ __forceinline__ float bf2f(unsigned h) { return __uint_as_float(h << 16); }
__device__ __forceinline__ unsigned pk2(float lo, float hi) { return pg8::cvt_pk_bf16(lo, hi); }
__device__ __forceinline__ float wave_sum(float v) {
#pragma unroll
    for (int o = 1; o < 64; o <<= 1) v += __shfl_xor(v, o);
    return v;
}
__device__ __forceinline__ f32x4 mfma16(bf16x8 a, bf16x8 b, f32x4 c) { return __builtin_amdgcn_mfma_f32_16x16x32_bf16(a, b, c, 0, 0, 0); }

__device__ __forceinline__ void transpose_item(const float* W, int K, int N, bf16* WT, int k0, int n0, int drow0, LAS float* scr, int lane) {
#pragma unroll 8
    for (int i = 0; i < 32; ++i) { const int kk = 2 * i + (lane >> 5); scr[kk * 33 + (lane & 31)] = W[(size_t)(k0 + kk) * N + n0 + (lane & 31)]; }
    asm volatile("s_waitcnt lgkmcnt(0)" ::: "memory");
    const int c = lane & 7;
#pragma unroll
    for (int j = 0; j < 4; ++j) { const int n = (lane >> 3) + 8 * j; const LAS float* s = scr + (8 * c) * 33 + n;
        v4u o; o.x = pk2(s[0 * 33], s[1 * 33]); o.y = pk2(s[2 * 33], s[3 * 33]); o.z = pk2(s[4 * 33], s[5 * 33]); o.w = pk2(s[6 * 33], s[7 * 33]);
        *(v4u*)(WT + (size_t)(drow0 + n) * K + k0 + 8 * c) = o; }
    asm volatile("s_waitcnt lgkmcnt(0)" ::: "memory");
}
template <bool WF32, bool WBF, bool WST>
__device__ __forceinline__ void ln_row(const float* xrow, const float* g, const float* b, float* of32, bf16* obf, float* stats, int lane) {
    const f32x4* xr = (const f32x4*)xrow + lane;
    f32x4 v[4]; float s = 0.f;
#pragma unroll
    for (int j = 0; j < 4; ++j) { v[j] = xr[64 * j]; s += (v[j].x + v[j].y) + (v[j].z + v[j].w); }
    const float mean = wave_sum(s) * (1.f / D); float s2 = 0.f;
#pragma unroll
    for (int j = 0; j < 4; ++j) { v[j] = v[j] - mean; s2 += (v[j].x * v[j].x + v[j].y * v[j].y) + (v[j].z * v[j].z + v[j].w * v[j].w); }
    const float rstd = 1.f / sqrtf(wave_sum(s2) * (1.f / D) + LN_EPS);
    if (WST) { if (lane == 0) { stats[0] = mean; stats[1] = rstd; } }
#pragma unroll
    for (int j = 0; j < 4; ++j) {
        const f32x4 gv = *((const f32x4*)g + lane + 64 * j), bv = *((const f32x4*)b + lane + 64 * j);
        const f32x4 y = v[j] * rstd * gv + bv;
        if (WF32) *((f32x4*)of32 + lane + 64 * j) = y;
        if (WBF) { v2u o; o.x = pk2(y.x, y.y); o.y = pk2(y.z, y.w); *((v2u*)obf + lane + 64 * j) = o; }
    }
}

struct EpiProj {
    static constexpr bool PERM = true, AFTER_DRAIN = false;
    bf16 *QA, *KA, *QB, *KB, *VBT, *GA, *GB; const float* bias; const float* cs;
    __device__ __forceinline__ void operator()(const f32x4 (&acc)[2][2][4][2], const pg8::Unit& u, int wr, int wc, int fr, int fq) const {
        const int row0 = u.pm * 256 + wr * 64 + fr;
#pragma unroll
        for (int bj = 0; bj < 2; ++bj) {
            const int cb = u.pn * 256 + bj * 128;
            const int c = cb + wc * 32 + 8 * fq;
            const int src = c < 1024 ? c : c + 512;
            const f32x4 b0 = *(const f32x4*)(bias + src), b1 = *(const f32x4*)(bias + src + 4);
            int kind; bf16* dst; int ld, coff;
            if (cb < 512) { kind = 0; dst = QA; ld = 512; coff = c; }
            else if (cb < 1024) { kind = 1; dst = KA; ld = 512; coff = c - 512; }
            else if (cb < 1536) { kind = 2; dst = QB; ld = 512; coff = c - 1024; }
            else if (cb < 1664) { kind = 3; dst = KB; ld = 128; coff = c - 1536; }
            else if (cb < 1792) { kind = 4; dst = VBT; ld = 0; coff = c - 1664; }
            else if (cb < 2816) { kind = 5; dst = GA; ld = 1024; coff = c - 1792; }
            else { kind = 5; dst = GB; ld = 1024; coff = c - 2816; }
            const bool rot = (kind == 2 || kind == 3) && ((wc & 1) == 0);
#pragma unroll
            for (int ai = 0; ai < 2; ++ai)
#pragma unroll
                for (int m = 0; m < 4; ++m) {
                    const int row = row0 + ai * 128 + m * 16;
                    f32x4 v0 = acc[ai][bj][m][0] + b0, v1 = acc[ai][bj][m][1] + b1;
                    if (rot) {
                        const float* t = cs + (size_t)(row & (SEQ - 1)) * 16;
                        const f32x4 c0 = *(const f32x4*)t, c1 = *(const f32x4*)(t + 4), s0 = *(const f32x4*)(t + 8), s1 = *(const f32x4*)(t + 12);
                        f32x4 p0, p1;
#pragma unroll
                        for (int e = 0; e < 4; ++e) { p0[e] = __shfl_xor(v0[e], 16); p1[e] = __shfl_xor(v1[e], 16); }
                        const float sg = (fq == 0) ? -1.f : 1.f;
                        if (fq < 2) { v0 = v0 * c0 + (p0 * sg) * s0; v1 = v1 * c1 + (p1 * sg) * s1; }
                    }
                    if (kind == 0 || kind == 2) { v0 = v0 * 0.125f; v1 = v1 * 0.125f; }
                    if (kind == 5) {
#pragma unroll
                        for (int e = 0; e < 4; ++e) { v0[e] = 1.f / (1.f + __expf(-v0[e])); v1[e] = 1.f / (1.f + __expf(-v1[e])); }
                    }
                    if (kind == 4) {
#pragma unroll
                        for (int e = 0; e < 4; ++e) { dst[(size_t)(coff + e) * M + row] = (bf16)(pk2(v0[e], 0.f) & 0xffffu); dst[(size_t)(coff + 4 + e) * M + row] = (bf16)(pk2(v1[e], 0.f) & 0xffffu); }
                    } else {
                        v4u w; w.x = pk2(v0[0], v0[1]); w.y = pk2(v0[2], v0[3]); w.z = pk2(v1[0], v1[1]); w.w = pk2(v1[2], v1[3]);
                        *(v4u*)(dst + (size_t)row * ld + coff) = w;
                    }
                }
        }
    }
};
struct EpiVT {
    static constexpr bool PERM = true, AFTER_DRAIN = false;
    bf16* VAT; const float* bias;
    __device__ __forceinline__ void operator()(const f32x4 (&acc)[2][2][4][2], const pg8::Unit& u, int wr, int wc, int fr, int fq) const {
        const int row0 = u.pm * 256 + wr * 64 + fr, col0 = u.pn * 256 + wc * 32 + 8 * fq;
#pragma unroll
        for (int ai = 0; ai < 2; ++ai)
#pragma unroll
            for (int m = 0; m < 4; ++m) { const int row = row0 + ai * 128 + m * 16; const float b = bias[row];
#pragma unroll
                for (int bj = 0; bj < 2; ++bj) { const f32x4 v0 = acc[ai][bj][m][0] + b, v1 = acc[ai][bj][m][1] + b;
                    v4u w; w.x = pk2(v0[0], v0[1]); w.y = pk2(v0[2], v0[3]); w.z = pk2(v1[0], v1[1]); w.w = pk2(v1[2], v1[3]);
                    *(v4u*)(VAT + (size_t)row * M + col0 + bj * 128) = w; } }
    }
};
template <int MODE> struct EpiGate {
    static constexpr bool PERM = true, AFTER_DRAIN = false;
    bf16* T; const bf16* G;
    __device__ __forceinline__ void operator()(const f32x4 (&acc)[2][2][4][2], const pg8::Unit& u, int wr, int wc, int fr, int fq) const {
        const int row0 = u.pm * 256 + wr * 64 + fr, col0 = u.pn * 256 + wc * 32 + 8 * fq;
#pragma unroll
        for (int ai = 0; ai < 2; ++ai)
#pragma unroll
            for (int m = 0; m < 4; ++m)
#pragma unroll
                for (int bj = 0; bj < 2; ++bj) {
                    const size_t off = (size_t)(row0 + ai * 128 + m * 16) * D + col0 + bj * 128;
                    const v4u gw = *(const v4u*)(G + off);
                    float r[8];
                    const f32x4 a0 = acc[ai][bj][m][0], a1 = acc[ai][bj][m][1];
                    r[0] = bf2f(gw.x & 0xffffu) * a0[0]; r[1] = bf2f(gw.x >> 16) * a0[1]; r[2] = bf2f(gw.y & 0xffffu) * a0[2]; r[3] = bf2f(gw.y >> 16) * a0[3];
                    r[4] = bf2f(gw.z & 0xffffu) * a1[0]; r[5] = bf2f(gw.z >> 16) * a1[1]; r[6] = bf2f(gw.w & 0xffffu) * a1[2]; r[7] = bf2f(gw.w >> 16) * a1[3];
                    if (MODE == 1) { const v4u tw = *(const v4u*)(T + off);
                        r[0] += bf2f(tw.x & 0xffffu); r[1] += bf2f(tw.x >> 16); r[2] += bf2f(tw.y & 0xffffu); r[3] += bf2f(tw.y >> 16);
                        r[4] += bf2f(tw.z & 0xffffu); r[5] += bf2f(tw.z >> 16); r[6] += bf2f(tw.w & 0xffffu); r[7] += bf2f(tw.w >> 16); }
                    v4u w; w.x = pk2(r[0], r[1]); w.y = pk2(r[2], r[3]); w.z = pk2(r[4], r[5]); w.w = pk2(r[6], r[7]);
                    *(v4u*)(T + off) = w;
                }
    }
};
struct EpiZ1 {
    static constexpr bool PERM = false, AFTER_DRAIN = false;
    float* Z; const float* x; const float* stats; const float* g0; const float* b0; const float* bias;
    __device__ __forceinline__ void operator()(const f32x4 (&acc)[2][2][4][2], const pg8::Unit& u, int wr, int wc, int fr, int fq) const {
        const int row0 = u.pm * 256 + wr * 64 + fr, col0 = u.pn * 256 + wc * 32 + 4 * fq;
#pragma unroll
        for (int ai = 0; ai < 2; ++ai)
#pragma unroll
            for (int m = 0; m < 4; ++m) { const int row = row0 + ai * 128 + m * 16; const float mean = stats[2 * row], rstd = stats[2 * row + 1];
#pragma unroll
                for (int bj = 0; bj < 2; ++bj)
#pragma unroll
                    for (int n = 0; n < 2; ++n) { const int col = col0 + bj * 128 + n * 16; const size_t off = (size_t)row * D + col;
                        const f32x4 xv = *(const f32x4*)(x + off), gv = *(const f32x4*)(g0 + col), bv = *(const f32x4*)(b0 + col), bb = *(const f32x4*)(bias + col);
                        const f32x4 h0 = (xv - mean) * rstd * gv + bv;
                        *(f32x4*)(Z + off) = acc[ai][bj][m][n] + bb + h0 * ALPHA; } }
    }
};
struct EpiFf1 {
    static constexpr bool PERM = true, AFTER_DRAIN = false;
    bf16* U; const float* bias;
    __device__ __forceinline__ void operator()(const f32x4 (&acc)[2][2][4][2], const pg8::Unit& u, int wr, int wc, int fr, int fq) const {
        const int row0 = u.pm * 256 + wr * 64 + fr, col0 = u.pn * 256 + wc * 32 + 8 * fq;
#pragma unroll
        for (int bj = 0; bj < 2; ++bj) { const f32x4 b0 = *(const f32x4*)(bias + col0 + bj * 128), b1 = *(const f32x4*)(bias + col0 + bj * 128 + 4);
#pragma unroll
            for (int ai = 0; ai < 2; ++ai)
#pragma unroll
                for (int m = 0; m < 4; ++m) { f32x4 v0 = acc[ai][bj][m][0] + b0, v1 = acc[ai][bj][m][1] + b1;
#pragma unroll
                    for (int e = 0; e < 4; ++e) { const float a = fmaxf(v0[e], 0.f), b = fmaxf(v1[e], 0.f); v0[e] = a * a; v1[e] = b * b; }
                    v4u w; w.x = pk2(v0[0], v0[1]); w.y = pk2(v0[2], v0[3]); w.z = pk2(v1[0], v1[1]); w.w = pk2(v1[2], v1[3]);
                    *(v4u*)(U + (size_t)(row0 + ai * 128 + m * 16) * FF + col0 + bj * 128) = w; } }
    }
};
struct EpiZ2 {
    static constexpr bool PERM = false, AFTER_DRAIN = false;
    float* Z; const float* bias;
    __device__ __forceinline__ void operator()(const f32x4 (&acc)[2][2][4][2], const pg8::Unit& u, int wr, int wc, int fr, int fq) const {
        const int row0 = u.pm * 256 + wr * 64 + fr, col0 = u.pn * 256 + wc * 32 + 4 * fq;
#pragma unroll
        for (int ai = 0; ai < 2; ++ai)
#pragma unroll
            for (int m = 0; m < 4; ++m) { const int row = row0 + ai * 128 + m * 16;
#pragma unroll
                for (int bj = 0; bj < 2; ++bj)
#pragma unroll
                    for (int n = 0; n < 2; ++n) { const int col = col0 + bj * 128 + n * 16; const size_t off = (size_t)row * D + col;
                        const f32x4 hv = *(const f32x4*)(Z + off), bb = *(const f32x4*)(bias + col);
                        *(f32x4*)(Z + off) = acc[ai][bj][m][n] + bb + hv * ALPHA; } }
    }
};

constexpr float L2E = 1.4426950408889634f;
__device__ __forceinline__ void na_unit(const bf16* QA, const bf16* KA, const bf16* VAT, bf16* O, const LAS float* rpb, int b, int h, int r, int cb, int lane) {
    const int n = lane & 15, rq = lane >> 4;
    const int rs = min(max(r - 4, 0), 120);
    const int kc0 = cb == 0 ? 0 : cb == 1 ? 8 : cb == 2 ? 24 : 32;
    const size_t tokb = (size_t)b * SEQ;
    const size_t qtok = tokb + r * 64 + cb * 16 + n;
    const bf16* qp = QA + qtok * 512 + h * 64 + rq * 8;
    const bf16x8 q0 = *(const bf16x8*)qp, q1 = *(const bf16x8*)(qp + 32);
    f32x4 s[16];
    const bf16* kbase = KA + (tokb + (size_t)rs * 64 + kc0 + n) * 512 + h * 64 + rq * 8;
    {
        bf16x8 kf[32];
#pragma unroll
        for (int jb = 0; jb < 16; ++jb) {
            const bf16* kp = kbase + (size_t)((jb >> 1) * 64 + (jb & 1) * 16) * 512;
            kf[2 * jb] = *(const bf16x8*)kp; kf[2 * jb + 1] = *(const bf16x8*)(kp + 32);
        }
        __builtin_amdgcn_sched_barrier(0);
#pragma unroll
        for (int jb = 0; jb < 16; ++jb) {
            f32x4 a = {0.f, 0.f, 0.f, 0.f};
            a = mfma16(kf[2 * jb], q0, a); a = mfma16(kf[2 * jb + 1], q1, a); s[jb] = a;
        }
    }
    const bf16* vbase = VAT + (size_t)(h * 64 + n) * M + tokb + (size_t)rs * 64 + kc0 + 4 * rq;
    v2u vlo[32], vhi[32];
#pragma unroll
    for (int kr = 0; kr < 4; ++kr)
#pragma unroll
        for (int dt = 0; dt < 4; ++dt) { const bf16* vp = vbase + (size_t)dt * 16 * M + kr * 64; vlo[kr * 4 + dt] = *(const v2u*)vp; vhi[kr * 4 + dt] = *(const v2u*)(vp + 16); }
    __builtin_amdgcn_sched_barrier(0);
    const int c = 16 * cb + n, cs = min(max(c - 8, 0), 48);
    float mx = -1e30f;
#pragma unroll
    for (int jb = 0; jb < 16; ++jb) {
        const int kr = jb >> 1, half = jb & 1;
        const LAS float* rp = rpb + (h * 15 + (rs + kr - r) + 7) * 31;
#pragma unroll
        for (int e = 0; e < 4; ++e) {
            const int kc = kc0 + 16 * half + 4 * rq + e;
            const bool valid = (kc >= cs) && (kc < cs + 16);
            const int idx = min(max(kc - c + 15, 0), 30);
            const float v = valid ? s[jb][e] + rp[idx] : -1e30f;
            s[jb][e] = v; mx = fmaxf(mx, v);
        }
    }
    mx = fmaxf(mx, __shfl_xor(mx, 16)); mx = fmaxf(mx, __shfl_xor(mx, 32));
    float sum = 0.f;
#pragma unroll
    for (int jb = 0; jb < 16; ++jb)
#pragma unroll
        for (int e = 0; e < 4; ++e) { const float p = __builtin_amdgcn_exp2f((s[jb][e] - mx) * L2E); s[jb][e] = p; sum += p; }
    sum += __shfl_xor(sum, 16); sum += __shfl_xor(sum, 32);
    const float inv = 1.f / sum;
    f32x4 o[4];
#pragma unroll
    for (int dt = 0; dt < 4; ++dt) o[dt] = (f32x4){0.f, 0.f, 0.f, 0.f};
    bf16x8 pbs[8];
#pragma unroll
    for (int kr = 0; kr < 8; ++kr) {
        v4u pw; pw.x = pk2(s[2 * kr][0], s[2 * kr][1]); pw.y = pk2(s[2 * kr][2], s[2 * kr][3]); pw.z = pk2(s[2 * kr + 1][0], s[2 * kr + 1][1]); pw.w = pk2(s[2 * kr + 1][2], s[2 * kr + 1][3]);
        pbs[kr] = __builtin_bit_cast(bf16x8, pw);
    }
#pragma unroll
    for (int kr = 4; kr < 8; ++kr)
#pragma unroll
        for (int dt = 0; dt < 4; ++dt) { const bf16* vp = vbase + (size_t)dt * 16 * M + kr * 64; vlo[kr * 4 + dt] = *(const v2u*)vp; vhi[kr * 4 + dt] = *(const v2u*)(vp + 16); }
    __builtin_amdgcn_sched_barrier(0);
#pragma unroll
    for (int kr = 0; kr < 8; ++kr) {
        const bf16x8 pb = pbs[kr];
#pragma unroll
        for (int dt = 0; dt < 4; ++dt) {
            const v2u lo = vlo[kr * 4 + dt], hi = vhi[kr * 4 + dt];
            v4u vw; vw.x = lo.x; vw.y = lo.y; vw.z = hi.x; vw.w = hi.y;
            o[dt] = mfma16(__builtin_bit_cast(bf16x8, vw), pb, o[dt]);
        }
    }
    bf16* op = O + qtok * 512 + h * 64 + 4 * rq;
#pragma unroll
    for (int dt = 0; dt < 4; ++dt) { v2u w; w.x = pk2(o[dt][0] * inv, o[dt][1] * inv); w.y = pk2(o[dt][2] * inv, o[dt][3] * inv); *(v2u*)(op + dt * 16) = w; }
}
__device__ __forceinline__ void swa_unit(const bf16* QB, const bf16* KB, const bf16* VBT, bf16* O, const float* sink, int b, int hq, int qb16, int lane) {
    const int n = lane & 15, rq = lane >> 4, g = hq >> 2, i0 = qb16 * 16;
    const size_t tokb = (size_t)b * SEQ;
    const size_t qtok = tokb + i0 + n;
    const bf16* qp = QB + qtok * 512 + hq * 64 + rq * 8;
    const bf16x8 q0 = *(const bf16x8*)qp, q1 = *(const bf16x8*)(qp + 32);
    f32x4 s[18];
    {
        bf16x8 kf[36];
#pragma unroll
        for (int jb = 0; jb < 18; ++jb) {
            const int kc = min(max(i0 - 128 + 16 * jb, 0), SEQ - 16);
            const bf16* kp = KB + (tokb + kc + n) * 128 + g * 64 + rq * 8;
            kf[2 * jb] = *(const bf16x8*)kp; kf[2 * jb + 1] = *(const bf16x8*)(kp + 32);
        }
        __builtin_amdgcn_sched_barrier(0);
#pragma unroll
        for (int jb = 0; jb < 18; ++jb) {
            f32x4 a = {0.f, 0.f, 0.f, 0.f};
            a = mfma16(kf[2 * jb], q0, a); a = mfma16(kf[2 * jb + 1], q1, a); s[jb] = a;
        }
    }
    const bf16* vbase = VBT + (size_t)(g * 64 + n) * M + tokb + 4 * rq;
    v2u vlo[36], vhi[36];
#pragma unroll
    for (int ks = 0; ks < 5; ++ks) {
        const int kc0 = min(max(i0 - 128 + 32 * ks, 0), SEQ - 16), kc1 = min(max(i0 - 128 + 32 * ks + 16, 0), SEQ - 16);
#pragma unroll
        for (int dt = 0; dt < 4; ++dt) { const bf16* vp = vbase + (size_t)dt * 16 * M; vlo[ks * 4 + dt] = *(const v2u*)(vp + kc0); vhi[ks * 4 + dt] = *(const v2u*)(vp + kc1); }
    }
    __builtin_amdgcn_sched_barrier(0);
    const float sk = sink[hq];
    float mx = sk;
#pragma unroll
    for (int jb = 0; jb < 18; ++jb)
#pragma unroll
        for (int e = 0; e < 4; ++e) {
            const int kpos = i0 - 128 + 16 * jb + 4 * rq + e, rel = kpos - (i0 + n);
            const bool valid = (kpos >= 0) && (kpos < SEQ) && (rel >= -128) && (rel <= 128);
            const float v = valid ? s[jb][e] : -1e30f;
            s[jb][e] = v; mx = fmaxf(mx, v);
        }
    mx = fmaxf(mx, __shfl_xor(mx, 16)); mx = fmaxf(mx, __shfl_xor(mx, 32));
    float sum = 0.f;
#pragma unroll
    for (int jb = 0; jb < 18; ++jb)
#pragma unroll
        for (int e = 0; e < 4; ++e) { const float p = __builtin_amdgcn_exp2f((s[jb][e] - mx) * L2E); s[jb][e] = p; sum += p; }
    sum += __shfl_xor(sum, 16); sum += __shfl_xor(sum, 32);
    sum += __builtin_amdgcn_exp2f((sk - mx) * L2E);
    const float inv = 1.f / sum;
    f32x4 o[4];
#pragma unroll
    for (int dt = 0; dt < 4; ++dt) o[dt] = (f32x4){0.f, 0.f, 0.f, 0.f};
    bf16x8 pbs[9];
#pragma unroll
    for (int ks = 0; ks < 9; ++ks) {
        v4u pw; pw.x = pk2(s[2 * ks][0], s[2 * ks][1]); pw.y = pk2(s[2 * ks][2], s[2 * ks][3]); pw.z = pk2(s[2 * ks + 1][0], s[2 * ks + 1][1]); pw.w = pk2(s[2 * ks + 1][2], s[2 * ks + 1][3]);
        pbs[ks] = __builtin_bit_cast(bf16x8, pw);
    }
#pragma unroll
    for (int ks = 5; ks < 9; ++ks) {
        const int kc0 = min(max(i0 - 128 + 32 * ks, 0), SEQ - 16), kc1 = min(max(i0 - 128 + 32 * ks + 16, 0), SEQ - 16);
#pragma unroll
        for (int dt = 0; dt < 4; ++dt) { const bf16* vp = vbase + (size_t)dt * 16 * M; vlo[ks * 4 + dt] = *(const v2u*)(vp + kc0); vhi[ks * 4 + dt] = *(const v2u*)(vp + kc1); }
    }
    __builtin_amdgcn_sched_barrier(0);
#pragma unroll
    for (int ks = 0; ks < 9; ++ks) {
        const bf16x8 pb = pbs[ks];
#pragma unroll
        for (int dt = 0; dt < 4; ++dt) {
            const v2u lo = vlo[ks * 4 + dt], hi = vhi[ks * 4 + dt];
            v4u vw; vw.x = lo.x; vw.y = lo.y; vw.z = hi.x; vw.w = hi.y;
            o[dt] = mfma16(__builtin_bit_cast(bf16x8, vw), pb, o[dt]);
        }
    }
    bf16* op = O + qtok * 512 + hq * 64 + 4 * rq;
#pragma unroll
    for (int dt = 0; dt < 4; ++dt) { v2u w; w.x = pk2(o[dt][0] * inv, o[dt][1] * inv); w.y = pk2(o[dt][2] * inv, o[dt][3] * inv); *(v2u*)(op + dt * 16) = w; }
}

#define XB_TMO      128
#define XB_XCNT(j)  (256  + 64 * (j))
#define XB_XSUB(j)  (1280 + 64 * (j))
#define XB_XGEN(j)  (2304 + 64 * (j))
#define XB_TOP      3328
#define XB_TOPGEN   3392
#define XCD_BAR_WORDS 3456
#define XB_SPIN_CAP (1u << 18)

__device__ __forceinline__ unsigned xb_ld(unsigned* p)              { return __hip_atomic_load(p, __ATOMIC_RELAXED, __HIP_MEMORY_SCOPE_AGENT); }
__device__ __forceinline__ unsigned xb_add(unsigned* p, unsigned v) { return __hip_atomic_fetch_add(p, v, __ATOMIC_RELAXED, __HIP_MEMORY_SCOPE_AGENT); }
__device__ __forceinline__ unsigned xb_xcc_id() { return (unsigned)__builtin_amdgcn_s_getreg((3 << 11) | 20) & 0xFu; }
#define XB_SPIN(cond, bar) do { unsigned _sp = 0; while (cond) { __builtin_amdgcn_s_sleep(1); \
    if ((++_sp & 255u) == 0u) { if (xb_ld(&(bar)[XB_TMO])) break; if (_sp > XB_SPIN_CAP) { atomicAdd(&(bar)[XB_TMO], 1u); break; } } } } while (0)

struct XcdBarrier {
    unsigned* bar; unsigned x;
    volatile LAS unsigned* st;
};

__device__ __forceinline__ XcdBarrier xcd_barrier_post(unsigned* bar, volatile LAS unsigned* st) {
    XcdBarrier b; b.bar = bar; b.x = xb_xcc_id(); b.st = st;
    if (threadIdx.x == 0) (void)xb_add(&bar[XB_XCNT(b.x)], 1u);
    return b;
}
__device__ __forceinline__ void xcd_barrier_complete(unsigned* bar, unsigned x, unsigned& nloc, unsigned& nx) {
    const unsigned G = gridDim.x * gridDim.y * gridDim.z;
    unsigned sum, cnt, mine, sp = 0u;
    for (;;) {
        sum = 0u; cnt = 0u; mine = 0u;
#pragma unroll
        for (unsigned j = 0; j < 16; ++j) { const unsigned c = xb_ld(&bar[XB_XCNT(j)]); sum += c; cnt += (c > 0u) ? 1u : 0u; mine = (j == x) ? c : mine; }
        if (sum == G) break;
        __builtin_amdgcn_s_sleep(1);
        if ((++sp & 255u) == 0u) { if (xb_ld(&bar[XB_TMO])) break; if (sp > XB_SPIN_CAP) { atomicAdd(&bar[XB_TMO], 1u); break; } }
    }
    nloc = mine > 0u ? mine : 1u; nx = cnt > 0u ? cnt : 1u;
}

__device__ __forceinline__ void xcd_barrier(const XcdBarrier& b) {
    asm volatile("s_waitcnt vmcnt(0)" ::: "memory");
    __syncthreads();
    if (threadIdx.x == 0) {
        unsigned* bar = b.bar;
        __builtin_amdgcn_s_waitcnt(0);
        unsigned nloc = b.st[0], nx = b.st[1];
        if (nloc == 0u) { xcd_barrier_complete(bar, b.x, nloc, nx); b.st[0] = nloc; b.st[1] = nx; }
        const unsigned old = xb_add(&bar[XB_XSUB(b.x)], 1u);
        const unsigned gen = old / nloc;
        if (old + 1u == (gen + 1u) * nloc) {
            __builtin_amdgcn_fence(__ATOMIC_RELEASE, "agent");
            asm volatile("s_waitcnt vmcnt(0)" ::: "memory");
            const unsigned og = xb_add(&bar[XB_TOP], 1u);
            const unsigned tg = og / nx;
            if (og + 1u == (tg + 1u) * nx) xb_add(&bar[XB_TOPGEN], 1u);
            else XB_SPIN(xb_ld(&bar[XB_TOPGEN]) == tg, bar);
            __builtin_amdgcn_fence(__ATOMIC_ACQUIRE, "agent");
            xb_add(&bar[XB_XGEN(b.x)], 1u);
            asm volatile("s_waitcnt vmcnt(0)" ::: "memory");
        } else {
            XB_SPIN(xb_ld(&bar[XB_XGEN(b.x)]) == gen, bar);
            __builtin_amdgcn_fence(__ATOMIC_ACQUIRE, "agent");
            asm volatile("s_waitcnt vmcnt(0)" ::: "memory");
        }
    }
    __syncthreads();
}

#ifndef CG_SYNC_AT_START
#define CG_SYNC_AT_START 1
#endif
#ifndef SYNC_REP
#define SYNC_REP 1
#endif
#ifndef P0_REP
#define P0_REP 1
#endif
#ifndef P1_REP
#define P1_REP 1
#endif
#ifndef P3_REP
#define P3_REP 1
#endif
#ifndef P4_REP
#define P4_REP 1
#endif
#ifndef P5_REP
#define P5_REP 1
#endif
#ifndef ATT_REP
#define ATT_REP 1
#endif
struct Args { const float* in[19]; float* out; unsigned char* ws; int naive; int pad; };
enum { I_X = 0, I_LN0G, I_LN0B, I_WIN, I_BIN, I_RPB, I_SINK, I_WBNA, I_WBSWA, I_WOUT, I_BOUT, I_LN1G, I_LN1B, I_W1, I_B1, I_W2, I_B2, I_LN2G, I_LN2B };

__global__ void __launch_bounds__(NTHREADS, 2) fwd_kernel(Args a) {
    extern __shared__ __attribute__((aligned(16))) unsigned char lds_raw[];
    cg::grid_group grid = cg::this_grid();
    LAS unsigned char* lds = (LAS unsigned char*)lds_raw;
    const int tid = threadIdx.x, lane = tid & 63, wave = __builtin_amdgcn_readfirstlane(tid >> 6);
    const int G = gridDim.x, gw = blockIdx.x * NWAVES + wave, NGW = G * NWAVES;
    unsigned char* ws = a.ws;
    volatile LAS unsigned* MISC = (volatile LAS unsigned*)(lds + 131072);
    if (tid < 16) MISC[tid] = 0u;
    __syncthreads();
    XcdBarrier bar = xcd_barrier_post((unsigned*)(ws + WS_BAR), MISC + 8);
#if CG_SYNC_AT_START
    grid.sync();
#else
    if (a.pad == 0x5eed) grid.sync();
#endif
    float* stats = (float*)(ws + WS_STATS); float* cs = (float*)(ws + WS_CS);
    bf16* Win_t = (bf16*)(ws + WS_WIN); bf16* Wbna_t = (bf16*)(ws + WS_WBNA); bf16* Wbswa_t = (bf16*)(ws + WS_WBSWA); bf16* Wout_t = (bf16*)(ws + WS_WOUT);
    bf16* W1_t = (bf16*)(ws + WS_W1); bf16* W2_t = (bf16*)(ws + WS_W2);
    bf16* XN = (bf16*)(ws + WS_XN); bf16* QA = (bf16*)(ws + WS_QA); bf16* QB = (bf16*)(ws + WS_QB); bf16* KA = (bf16*)(ws + WS_KA); bf16* VAT = (bf16*)(ws + WS_VAT);
    bf16* KB = (bf16*)(ws + WS_KB); bf16* VBT = (bf16*)(ws + WS_VBT); bf16* GA = (bf16*)(ws + WS_GA); bf16* GB = (bf16*)(ws + WS_GB); bf16* MIX = (bf16*)(ws + WS_MIX); bf16* U = (bf16*)(ws + WS_U); bf16* ONA = (bf16*)(ws + WS_ONA); bf16* OSWA = (bf16*)(ws + WS_OSWA);

    for (int rep_ = 0; rep_ < P0_REP; ++rep_) {
        LAS float* scr = (LAS float*)(lds + wave * 16384);
        constexpr int I_IN = (D / 64) * (NIN / 32), I_BR = (512 / 64) * (D / 32), I_O = (D / 64) * (D / 32), I_1 = (D / 64) * (FF / 32), I_2 = (FF / 64) * (D / 32);
        constexpr int NITEMS = I_IN + 2 * I_BR + I_O + I_1 + I_2;
        for (int it = gw; it < NITEMS; it += NGW) {
            int r = it;
            if (r < I_IN) { const int nblk = NIN / 32, kb = r / nblk, nb = r % nblk, n0 = nb * 32;
                const int drow = n0 < 1024 ? n0 : (n0 < 1536 ? NMAIN + (n0 - 1024) : n0 - 512);
                transpose_item(a.in[I_WIN], D, NIN, Win_t, kb * 64, n0, drow, scr, lane); continue; } r -= I_IN;
            if (r < I_BR) { const int nblk = D / 32; transpose_item(a.in[I_WBNA], 512, D, Wbna_t, (r / nblk) * 64, (r % nblk) * 32, (r % nblk) * 32, scr, lane); continue; } r -= I_BR;
            if (r < I_BR) { const int nblk = D / 32; transpose_item(a.in[I_WBSWA], 512, D, Wbswa_t, (r / nblk) * 64, (r % nblk) * 32, (r % nblk) * 32, scr, lane); continue; } r -= I_BR;
            if (r < I_O) { const int nblk = D / 32; transpose_item(a.in[I_WOUT], D, D, Wout_t, (r / nblk) * 64, (r % nblk) * 32, (r % nblk) * 32, scr, lane); continue; } r -= I_O;
            if (r < I_1) { const int nblk = FF / 32; transpose_item(a.in[I_W1], D, FF, W1_t, (r / nblk) * 64, (r % nblk) * 32, (r % nblk) * 32, scr, lane); continue; } r -= I_1;
            { const int nblk = D / 32; transpose_item(a.in[I_W2], FF, D, W2_t, (r / nblk) * 64, (r % nblk) * 32, (r % nblk) * 32, scr, lane); }
        }
        for (int m = gw; m < M; m += NGW) ln_row<false, true, true>(a.in[I_X] + (size_t)m * D, a.in[I_LN0G], a.in[I_LN0B], nullptr, XN + (size_t)m * D, stats + 2 * m, lane);
        for (int i = blockIdx.x * NTHREADS + tid; i < SEQ * 8; i += G * NTHREADS) {
            const int pos = i >> 3, j = i & 7;
            const float fr = j == 0 ? 1.0f : j == 1 ? 0.19392274f : j == 2 ? 0.03760603f : j == 3 ? 0.0072926646f : j == 4 ? 0.0014142136f : j == 5 ? 0.0002742482f : j == 6 ? 5.3182957e-05f : 1.0313385e-05f;
            const float ang = (float)pos * fr;
            double rv = (double)ang * 0.15915494309189535; rv -= __builtin_rint(rv);
            cs[pos * 16 + j] = __builtin_amdgcn_cosf((float)rv); cs[pos * 16 + 8 + j] = __builtin_amdgcn_sinf((float)rv);
        }
    }
    for (int rep_ = 0; rep_ < SYNC_REP; ++rep_) xcd_barrier(bar);
    for (int rep_ = 0; rep_ < P1_REP; ++rep_) {
        pg8::Gemm g{XN, Win_t, M, NMAIN, D}; pg8::StaticOrder S; S.init(M, NMAIN, G, (int)blockIdx.x);
        EpiProj E{QA, KA, QB, KB, VBT, GA, GB, a.in[I_BIN], cs};
        pg8::gemm_phase<EpiProj, pg8::StaticOrder, PG8_ALIGN, PG8_SP2>(lds, g, S, E);
        pg8::Gemm g2{Win_t + (size_t)NMAIN * D, XN, NVA, M, D}; pg8::StaticOrder S2; S2.init(NVA, M, G, (int)((blockIdx.x + 64) % G));
        EpiVT E2{VAT, a.in[I_BIN] + 1024};
        pg8::gemm_phase<EpiVT, pg8::StaticOrder, PG8_ALIGN, PG8_SP2>(lds, g2, S2, E2);
    }
    for (int rep_ = 0; rep_ < SYNC_REP; ++rep_) xcd_barrier(bar);
    for (int rep = 0; rep < ATT_REP; ++rep) {
        LAS float* rpb = (LAS float*)lds;
        for (int i = tid; i < 8 * 15 * 31; i += NTHREADS) rpb[i] = a.in[I_RPB][i];
        __syncthreads();
        for (int u = gw; u < 8192; u += NGW) na_unit(QA, KA, VAT, ONA, rpb, u >> 12, (u >> 9) & 7, (u >> 2) & 127, u & 3, lane);
        for (int u = gw; u < 8192; u += NGW) swa_unit(QB, KB, VBT, OSWA, a.in[I_SINK], u >> 12, ((u >> 11) & 1) * 4 + (u & 3), (u >> 2) & 511, lane);
    }
    for (int rep_ = 0; rep_ < SYNC_REP; ++rep_) xcd_barrier(bar);
    for (int rep_ = 0; rep_ < P3_REP; ++rep_) {
        pg8::StaticOrder S; S.init(M, D, G, (int)blockIdx.x);
        pg8::Gemm g1{ONA, Wbna_t, M, D, 512}; EpiGate<0> E1{MIX, GA};
        pg8::gemm_phase<EpiGate<0>, pg8::StaticOrder, PG8_ALIGN, PG8_SP2>(lds, g1, S, E1);
        pg8::Gemm g2{OSWA, Wbswa_t, M, D, 512}; EpiGate<1> E2{MIX, GB};
        pg8::gemm_phase<EpiGate<1>, pg8::StaticOrder, PG8_ALIGN, PG8_SP2>(lds, g2, S, E2);
    }
    for (int rep_ = 0; rep_ < SYNC_REP; ++rep_) xcd_barrier(bar);
    for (int rep_ = 0; rep_ < P4_REP; ++rep_) {
        pg8::StaticOrder S; S.init(M, D, G, (int)blockIdx.x);
        pg8::Gemm g{MIX, Wout_t, M, D, D}; EpiZ1 E{a.out, a.in[I_X], stats, a.in[I_LN0G], a.in[I_LN0B], a.in[I_BOUT]};
        pg8::gemm_phase<EpiZ1, pg8::StaticOrder, PG8_ALIGN, PG8_SP2>(lds, g, S, E);
    }
    for (int rep_ = 0; rep_ < SYNC_REP; ++rep_) xcd_barrier(bar);
    for (int m = gw; m < M; m += NGW) ln_row<true, true, false>(a.out + (size_t)m * D, a.in[I_LN1G], a.in[I_LN1B], a.out + (size_t)m * D, XN + (size_t)m * D, nullptr, lane);
    for (int rep_ = 0; rep_ < SYNC_REP; ++rep_) xcd_barrier(bar);
    for (int rep_ = 0; rep_ < P5_REP; ++rep_) {
        pg8::StaticOrder S; S.init(M, FF, G, (int)blockIdx.x);
        pg8::Gemm g{XN, W1_t, M, FF, D}; EpiFf1 E{U, a.in[I_B1]};
        pg8::gemm_phase<EpiFf1, pg8::StaticOrder, PG8_ALIGN, PG8_SP2>(lds, g, S, E);
    }
    for (int rep_ = 0; rep_ < SYNC_REP; ++rep_) xcd_barrier(bar);
    {
        pg8::StaticOrder S; S.init(M, D, G, (int)blockIdx.x);
        pg8::Gemm g{U, W2_t, M, D, FF}; EpiZ2 E{a.out, a.in[I_B2]};
        pg8::gemm_phase<EpiZ2, pg8::StaticOrder, PG8_ALIGN, PG8_SP2>(lds, g, S, E);
    }
    for (int rep_ = 0; rep_ < SYNC_REP; ++rep_) xcd_barrier(bar);
    for (int m = gw; m < M; m += NGW) ln_row<true, false, false>(a.out + (size_t)m * D, a.in[I_LN2G], a.in[I_LN2B], a.out + (size_t)m * D, nullptr, nullptr, lane);
}

#ifndef NAIVE_ATTN
#define NAIVE_ATTN 0
#endif
extern "C" void kernel_launch(void* const* d_in, const int* in_sizes, int n_in, void* d_out, int out_size, void* d_ws, size_t ws_size, hipStream_t stream) {
    static int grid = 0;
    if (grid == 0) {
        if (n_in != 19 || in_sizes[0] != M * D || out_size != M * D || ws_size < WS_END) { fprintf(stderr, "kernel_launch: unexpected shapes (n_in %d, in0 %d, out %d, ws %zu)\n", n_in, n_in > 0 ? in_sizes[0] : -1, out_size, ws_size); grid = -1; return; }
        int dev = 0, cus = 0, per_cu = 0;
        (void)hipGetDevice(&dev); (void)hipDeviceGetAttribute(&cus, hipDeviceAttributeMultiprocessorCount, dev);
        (void)hipFuncSetAttribute((const void*)fwd_kernel, hipFuncAttributeMaxDynamicSharedMemorySize, LDS_BYTES);
        (void)hipOccupancyMaxActiveBlocksPerMultiprocessor(&per_cu, (const void*)fwd_kernel, NTHREADS, LDS_BYTES);
        if (per_cu < 1) per_cu = 1;
        grid = cus * per_cu;
        (void)hipGetLastError();
    }
    if (grid < 0) return;
    if (hipMemsetAsync((char*)d_ws + WS_BAR, 0, BAR_BYTES, stream) != hipSuccess) { fprintf(stderr, "kernel_launch: memset of the barrier words failed\n"); return; }
    Args a{};
    for (int i = 0; i < 19; ++i) a.in[i] = (const float*)d_in[i];
    a.out = (float*)d_out; a.ws = (unsigned char*)d_ws; a.naive = NAIVE_ATTN; a.pad = 0;
    void* params[] = {&a};
    hipError_t e = hipLaunchCooperativeKernel((const void*)fwd_kernel, dim3(grid), dim3(NTHREADS), params, LDS_BYTES, stream);
    if (e != hipSuccess) fprintf(stderr, "cooperative launch failed: %s (grid %d)\n", hipGetErrorString(e), grid);
}
```

```cpp
#include <hip/hip_runtime.h>
#include <cstdio>
#include <cstdint>
namespace pg8 {
#define PG8_LAS __attribute__((address_space(3)))
typedef unsigned short bf16_t;
typedef short bf16x8 __attribute__((ext_vector_type(8)));
typedef float f32x4 __attribute__((ext_vector_type(4)));
typedef unsigned u32x4 __attribute__((ext_vector_type(4)));
constexpr int BM = 256, BK = 64, HALF = 128, HTB = HALF * BK * 2  , STAGE_BYTES = 8 * HTB, NXCD = 8, WGM = 8;

__host__ __device__ __forceinline__ int lds_byte(int r, int c) { const int st = (r >> 4) * 2 + (c >> 5), rr = r & 15, cc = c & 31, ob = rr * 64 + cc * 2; return st * 1024 + (ob ^ (((ob >> 9) & 1) << 5)); }
__host__ __device__ __forceinline__ void stage_rc(int b, int& R, int& C) { const int st = b / 1024, sb = b % 1024, swz = sb ^ (((sb >> 9) & 1) << 5); R = (st >> 1) * 16 + swz / 64; C = (st & 1) * 32 + (swz % 64) / 2; }
__host__ __device__ __forceinline__ int perm32(int rho) { const int n = rho >> 4, i = rho & 15; return 8 * (i >> 2) + 4 * n + (i & 3); }

struct Unit { int pm, pn; };
struct Gemm { const bf16_t* A; const bf16_t* Bt; int M, N, K; };

struct StaticOrder {
    int nM, nN, nwg, G, c;
    __host__ __device__ void init(int M, int N, int G_, int c_) { nM = M / BM; nN = N / BM; nwg = nM * nN; G = G_; c = c_; }
    __host__ __device__ bool next(int i, Unit& u) const {
        const long L = (long)i * G + c; if (L >= nwg) return false;
        int wgid = (int)L; { const int q = nwg / NXCD, r = nwg % NXCD, xcd = wgid % NXCD, off = wgid / NXCD; wgid = (xcd < r ? xcd * (q + 1) : r * (q + 1) + (xcd - r) * q) + off; }
        const int nig = WGM * nN, gid = wgid / nig, fm = gid * WGM, gsz = (nM - fm) < WGM ? (nM - fm) : WGM;
        u.pm = fm + ((wgid % nig) % gsz); u.pn = (wgid % nig) / gsz; return true;
    }
    __device__ __forceinline__ void a_ready(const Unit&) const {}
    __device__ __forceinline__ void done(const Unit&) const {}
};

__device__ __forceinline__ unsigned cvt_pk_bf16(float lo, float hi) { unsigned r; asm volatile("v_cvt_pk_bf16_f32 %0, %1, %2" : "=v"(r) : "v"(lo), "v"(hi)); return r; }
typedef float f32x2 __attribute__((ext_vector_type(2)));
__device__ __forceinline__ f32x2 gelu_pk(f32x2 v) {
    const f32x2 av = __builtin_elementwise_abs(v), d = av * 0.2316418882f + 1.0f;
    f32x2 t; t.x = __builtin_amdgcn_rcpf(d.x); t.y = __builtin_amdgcn_rcpf(d.y);
    f32x2 q = t * 0.5307027145f + (-0.7265760135f); q = q * t + 0.7107068705f; q = q * t + (-0.142248368f); q = q * t + 0.127414796f; q = q * t;
    const f32x2 s = (v * v) * (-0.72134752044f);
    f32x2 e; e.x = __builtin_amdgcn_exp2f(s.x); e.y = __builtin_amdgcn_exp2f(s.y);
    const f32x2 m = v * (q * e), r = v - m;
    f32x2 o; o.x = v.x < 0.f ? m.x : r.x; o.y = v.y < 0.f ? m.y : r.y; return o;
}

template <int ACT  > struct EpiBf16 {
    static constexpr bool PERM = true, AFTER_DRAIN = false; static_assert(ACT == 0 || ACT == 1, "EpiBf16: ACT is 0 (none) or 1 (gelu_pk)");
    bf16_t* O; int ldc; const float* bias; int split_cols; size_t split_stride; float scale0;
    __device__ __forceinline__ void operator()(const f32x4 (&acc)[2][2][4][2], const Unit& u, int wr, int wc, int fr, int fq) const {
        const int row0 = u.pm * BM + wr * 64 + fr; int colt = u.pn * BM; bf16_t* base = O;
        float sc = 1.f; if (split_cols) { const int t = colt / split_cols; base += (size_t)t * split_stride; colt -= t * split_cols; if (t == 0) sc = scale0; }
        const int col0 = colt + wc * 32 + 8 * fq, bcol0 = u.pn * BM + wc * 32 + 8 * fq;
        f32x4 bv[2][2];
#pragma unroll
        for (int bj = 0; bj < 2; ++bj)
#pragma unroll
            for (int n = 0; n < 2; ++n) bv[bj][n] = bias ? *(const f32x4*)(bias + bcol0 + bj * HALF + 4 * n) : (f32x4){0.f, 0.f, 0.f, 0.f};
#pragma unroll
        for (int ai = 0; ai < 2; ++ai)
#pragma unroll
            for (int m = 0; m < 4; ++m) { bf16_t* rowp = base + (size_t)(row0 + ai * HALF + m * 16) * ldc + col0;
#pragma unroll
                for (int bj = 0; bj < 2; ++bj) { f32x4 v0 = acc[ai][bj][m][0] + bv[bj][0], v1 = acc[ai][bj][m][1] + bv[bj][1];
                    if (ACT == 1) { f32x2 a = gelu_pk((f32x2){v0[0], v0[1]}), b = gelu_pk((f32x2){v0[2], v0[3]}), c = gelu_pk((f32x2){v1[0], v1[1]}), d = gelu_pk((f32x2){v1[2], v1[3]});
                        v0 = (f32x4){a.x, a.y, b.x, b.y}; v1 = (f32x4){c.x, c.y, d.x, d.y}; }
                    v0 = v0 * sc; v1 = v1 * sc; u32x4 w; w.x = cvt_pk_bf16(v0[0], v0[1]); w.y = cvt_pk_bf16(v0[2], v0[3]); w.z = cvt_pk_bf16(v1[0], v1[1]); w.w = cvt_pk_bf16(v1[2], v1[3]);
                    *(u32x4*)(rowp + bj * HALF) = w; } }
    }
};

struct PanelStats {
    unsigned* xbuf;
    unsigned* cnt;
    unsigned* tmo;
    int ntn; float eps;
    unsigned code;
    __device__ __forceinline__ bool run(const f32x4 (&v)[2][2][4][2], const Unit& u, int wr, int wc, int fr, int fq, PG8_LAS unsigned char* lds, int wid, int lane) const {
        typedef float f32x2v __attribute__((ext_vector_type(2)));
        PG8_LAS f32x2v* P = (PG8_LAS f32x2v*)lds;
        PG8_LAS f32x2v* S = (PG8_LAS f32x2v*)(lds + 8192);
        PG8_LAS unsigned* flag = (PG8_LAS unsigned*)(lds + 8192 + 2048);
#pragma unroll
        for (int ai = 0; ai < 2; ++ai)
#pragma unroll
            for (int m = 0; m < 4; ++m) {
                float s = 0.f;
#pragma unroll
                for (int bj = 0; bj < 2; ++bj)
#pragma unroll
                    for (int n = 0; n < 2; ++n) { const f32x4 x = v[ai][bj][m][n]; s += (x[0] + x[1]) + (x[2] + x[3]); }
                s += __shfl_xor(s, 16); s += __shfl_xor(s, 32);
                const float mw = s * (1.0f / 64.0f); float q = 0.f;
#pragma unroll
                for (int bj = 0; bj < 2; ++bj)
#pragma unroll
                    for (int n = 0; n < 2; ++n) { const f32x4 d = v[ai][bj][m][n] - mw; q += (d[0] * d[0] + d[1] * d[1]) + (d[2] * d[2] + d[3] * d[3]); }
                q += __shfl_xor(q, 16); q += __shfl_xor(q, 32);
                if (fq == 0) P[(ai * HALF + wr * 64 + m * 16 + fr) * 4 + wc] = (f32x2v){mw, q};
            }
        asm volatile("s_waitcnt lgkmcnt(0)" ::: "memory"); __builtin_amdgcn_s_barrier(); asm volatile("" ::: "memory");
#if defined(BROKEN_EXCHANGE_NO_WAIT)
#warning BROKEN CONTROL BUILD: the row-statistics exchange does not wait; results are wrong by design
        if (blockIdx.x >= 64) { const long long t0_ = clock64(); while (clock64() - t0_ < 60000) __builtin_amdgcn_s_sleep(8); }
#endif
        const int row = wid * 32 + (lane & 31);
        if (lane < 32) {
            const f32x2v a = P[row * 4 + 0], b = P[row * 4 + 1], c = P[row * 4 + 2], d = P[row * 4 + 3];
            const float mt = (a.x + b.x + c.x + d.x) * 0.25f;
            const float da = a.x - mt, db = b.x - mt, dc = c.x - mt, dd = d.x - mt;
            const float m2 = (a.y + b.y) + (c.y + d.y) + 64.0f * ((da * da + db * db) + (dc * dc + dd * dd));
            unsigned long long* slot = (unsigned long long*)xbuf + ((size_t)(u.pm * BM + row) * 4 + u.pn);
            __hip_atomic_store(slot, ((unsigned long long)__float_as_uint(m2) << 32) | __float_as_uint(mt), __ATOMIC_RELAXED, __HIP_MEMORY_SCOPE_AGENT);
        }
        asm volatile("s_waitcnt vmcnt(0)" ::: "memory");
        if (lane == 0) __hip_atomic_fetch_add(cnt + 64 * u.pm, 1u, __ATOMIC_RELAXED, __HIP_MEMORY_SCOPE_AGENT);
        if (wid == 0) {
            bool dead = false; const unsigned long long t0 = __builtin_amdgcn_s_memrealtime(); const unsigned want = 8u * (unsigned)ntn;
            for (;;) {
#if defined(BROKEN_EXCHANGE_NO_WAIT)
                break;
#endif
                if ((unsigned)__builtin_amdgcn_readfirstlane(__hip_atomic_load(cnt + 64 * u.pm, __ATOMIC_RELAXED, __HIP_MEMORY_SCOPE_AGENT)) >= want) break;
                if (__builtin_amdgcn_s_memrealtime() - t0 > 2000000ull) {
                    if (lane == 0) { unsigned expect = 0u; __hip_atomic_compare_exchange_strong(tmo + 1, &expect, code | (unsigned)(u.pm & 0xff), __ATOMIC_RELAXED, __ATOMIC_RELAXED, __HIP_MEMORY_SCOPE_AGENT);
                                     __hip_atomic_store(tmo, 1u, __ATOMIC_RELAXED, __HIP_MEMORY_SCOPE_AGENT); }
                    dead = true; break; }
                __builtin_amdgcn_s_sleep(2);
            }
            __builtin_amdgcn_fence(__ATOMIC_ACQUIRE, "agent");
            if (lane == 0) flag[0] = dead ? 1u : 0u;
        }
        asm volatile("s_waitcnt vmcnt(0) lgkmcnt(0)" ::: "memory"); __builtin_amdgcn_s_barrier(); asm volatile("" ::: "memory");
        const bool bad = flag[0] != 0u;
        if (lane < 32) {
            const unsigned long long* slot = (const unsigned long long*)xbuf + (size_t)(u.pm * BM + row) * 4; float mt[4], m2[4]; float ms = 0.f;
#pragma unroll
            for (int t = 0; t < 4; ++t) { if (t < ntn) { const unsigned long long w = __hip_atomic_load(slot + t, __ATOMIC_RELAXED, __HIP_MEMORY_SCOPE_AGENT); mt[t] = __uint_as_float((unsigned)w); m2[t] = __uint_as_float((unsigned)(w >> 32)); } else { mt[t] = 0.f; m2[t] = 0.f; } ms += mt[t]; }
            const float mean = ms / (float)ntn; float q = 0.f;
#pragma unroll
            for (int t = 0; t < 4; ++t) if (t < ntn) { const float dm = mt[t] - mean; q += m2[t] + 256.0f * dm * dm; }
            S[row] = (f32x2v){mean, 1.0f / sqrtf(q / (256.0f * (float)ntn) + eps)};
        }
        asm volatile("s_waitcnt lgkmcnt(0)" ::: "memory"); __builtin_amdgcn_s_barrier(); asm volatile("" ::: "memory");
        return bad;
    }
};
struct EpiLnRes {
    static constexpr bool PERM = false, AFTER_DRAIN = true;
    const float* base; float* out; int ldc; const float* bias; PanelStats st; unsigned poison;
    __device__ __forceinline__ void fused(f32x4 (&acc)[2][2][4][2], const Unit& u, int wr, int wc, int fr, int fq, PG8_LAS unsigned char* lds, int wid, int lane) const {
        typedef float f32x2v __attribute__((ext_vector_type(2)));
        const PG8_LAS f32x2v* S = (const PG8_LAS f32x2v*)(lds + 8192);
        const int col0 = u.pn * BM + wc * 32 + 4 * fq;
#pragma unroll
        for (int bj = 0; bj < 2; ++bj)
#pragma unroll
            for (int n = 0; n < 2; ++n) { const f32x4 bv = bias ? *(const f32x4*)(bias + col0 + bj * HALF + n * 16) : (f32x4){0.f, 0.f, 0.f, 0.f};
#pragma unroll
                for (int ai = 0; ai < 2; ++ai)
#pragma unroll
                    for (int m = 0; m < 4; ++m) acc[ai][bj][m][n] += bv; }
        f32x4 pre[4][2][2];
#pragma unroll
        for (int m = 0; m < 4; ++m) { const size_t off = (size_t)(u.pm * BM + wr * 64 + m * 16 + fr) * ldc + col0;
#pragma unroll
            for (int bj = 0; bj < 2; ++bj)
#pragma unroll
                for (int n = 0; n < 2; ++n) pre[m][bj][n] = *(const f32x4*)(base + off + bj * HALF + n * 16); }
        const bool bad = st.run(acc, u, wr, wc, fr, fq, lds, wid, lane) || poison != 0u;
        const float qnan = __builtin_nanf("");
#pragma unroll
        for (int ai = 0; ai < 2; ++ai)
#pragma unroll
            for (int m = 0; m < 4; ++m) { const int r = ai * HALF + wr * 64 + m * 16 + fr; const f32x2v sr = S[r]; const size_t off = (size_t)(u.pm * BM + r) * ldc + col0;
#pragma unroll
                for (int bj = 0; bj < 2; ++bj)
#pragma unroll
                    for (int n = 0; n < 2; ++n) { const f32x4 bs = ai == 0 ? pre[m][bj][n] : *(const f32x4*)(base + off + bj * HALF + n * 16); f32x4 o = bs + (acc[ai][bj][m][n] - sr.x) * sr.y;
                        if (bad) o = (f32x4){qnan, qnan, qnan, qnan}; *(f32x4*)(out + off + bj * HALF + n * 16) = o; }
                if (m & 1) asm volatile("" ::: "memory"); }
    }
};
struct EpiLnResLn {
    static constexpr bool PERM = false, AFTER_DRAIN = true;
    const float* base; float* out; bf16_t* xn; int ldc; const float* bias; PanelStats st1, st2; unsigned poison;
    __device__ __forceinline__ void fused(f32x4 (&acc)[2][2][4][2], const Unit& u, int wr, int wc, int fr, int fq, PG8_LAS unsigned char* lds, int wid, int lane) const {
        typedef float f32x2v __attribute__((ext_vector_type(2))); typedef unsigned u32x2v __attribute__((ext_vector_type(2)));
        const PG8_LAS f32x2v* S = (const PG8_LAS f32x2v*)(lds + 8192);
        const int col0 = u.pn * BM + wc * 32 + 4 * fq;
#pragma unroll
        for (int bj = 0; bj < 2; ++bj)
#pragma unroll
            for (int n = 0; n < 2; ++n) { const f32x4 bv = bias ? *(const f32x4*)(bias + col0 + bj * HALF + n * 16) : (f32x4){0.f, 0.f, 0.f, 0.f};
#pragma unroll
                for (int ai = 0; ai < 2; ++ai)
#pragma unroll
                    for (int m = 0; m < 4; ++m) acc[ai][bj][m][n] += bv; }
        bool bad = st1.run(acc, u, wr, wc, fr, fq, lds, wid, lane) || poison != 0u;
        const float qnan = __builtin_nanf("");
#pragma unroll
        for (int ai = 0; ai < 2; ++ai)
#pragma unroll
            for (int m = 0; m < 4; ++m) { const int r = ai * HALF + wr * 64 + m * 16 + fr; const f32x2v sr = S[r]; const size_t off = (size_t)(u.pm * BM + r) * ldc + col0;
#pragma unroll
                for (int bj = 0; bj < 2; ++bj)
#pragma unroll
                    for (int n = 0; n < 2; ++n) { const f32x4 bs = *(const f32x4*)(base + off + bj * HALF + n * 16); acc[ai][bj][m][n] = bs + (acc[ai][bj][m][n] - sr.x) * sr.y; }
                asm volatile("" : "+v"(acc[ai][0][m][0]), "+v"(acc[ai][0][m][1]), "+v"(acc[ai][1][m][0]), "+v"(acc[ai][1][m][1]));
                if (m & 1) asm volatile("" ::: "memory"); }
        const bool bad1 = bad;
        bad = st2.run(acc, u, wr, wc, fr, fq, lds, wid, lane) || bad;
#pragma unroll
        for (int ai = 0; ai < 2; ++ai)
#pragma unroll
            for (int m = 0; m < 4; ++m) { const int r = ai * HALF + wr * 64 + m * 16 + fr; const f32x2v sr = S[r]; const size_t off = (size_t)(u.pm * BM + r) * ldc + col0;
#pragma unroll
                for (int bj = 0; bj < 2; ++bj)
#pragma unroll
                    for (int n = 0; n < 2; ++n) { const f32x4 x1 = acc[ai][bj][m][n]; *(f32x4*)(out + off + bj * HALF + n * 16) = bad1 ? (f32x4){qnan, qnan, qnan, qnan} : x1;
                        const f32x4 o = (x1 - sr.x) * sr.y; u32x2v w; w.x = cvt_pk_bf16(o[0], o[1]); w.y = cvt_pk_bf16(o[2], o[3]);
                        if (bad) { w.x = 0x7fc07fc0u; w.y = 0x7fc07fc0u; } *(u32x2v*)(xn + off + bj * HALF + n * 16) = w; }
                asm volatile("" ::: "memory"); }
    }
};

template <class Epi, class Sched, bool ALIGN_EPI = false, bool SP2 = false>
__device__ __forceinline__ void gemm_phase(PG8_LAS unsigned char* lds, const Gemm g, const Sched& S, const Epi& E) {
    const int tid = threadIdx.x, wid = __builtin_amdgcn_readfirstlane(tid >> 6), lane = tid & 63, wr = wid >> 2, wc = wid & 3, fr = lane & 15, fq = lane >> 4;
    const int K = g.K, nt = K / BK;
    unsigned voffA[2], voffB[2];
#pragma unroll
    for (int i = 0; i < 2; ++i) { int R, C; stage_rc(tid * 16 + i * 8192, R, C); const int Rb = Epi::PERM ? ((R & ~31) + perm32(R & 31)) : R;
        voffA[i] = (unsigned)(R * K + C) * 2u; voffB[i] = (unsigned)(Rb * K + C) * 2u; }
    const size_t kstep = (size_t)(BK * 2);
    const size_t hstep = (size_t)HALF * K * 2;
    const size_t tstep = 2 * hstep;
    const unsigned ldsw = (unsigned)wid * 1024u;
    const int aoff = lds_byte(wr * 64 + fr, fq * 8), boff = lds_byte(wc * 32 + fr, fq * 8);
#define PG8_SA(b, h) (((b) * 2 + (h)) * HTB)
#define PG8_SB(b, h) ((4 + (b) * 2 + (h)) * HTB)
#define PG8_STAGE(bufoff, gbase, voff) do { _Pragma("unroll") for (int _i = 0; _i < 2; ++_i) \
        __builtin_amdgcn_global_load_lds((const unsigned*)((const char*)(gbase) + (voff)[_i]), (PG8_LAS unsigned*)(lds + (bufoff) + ldsw + _i * 8192), 16, 0, 0); } while (0)
#define PG8_LDA(dst, b, h) do { _Pragma("unroll") for (int m = 0; m < 4; ++m) _Pragma("unroll") for (int k = 0; k < 2; ++k) dst[m][k] = *(const PG8_LAS bf16x8*)(lds + PG8_SA(b, h) + aoff + m * 2048 + k * 1024); } while (0)
#define PG8_LDB(dst, b, h) do { _Pragma("unroll") for (int n = 0; n < 2; ++n) _Pragma("unroll") for (int k = 0; k < 2; ++k) dst[n][k] = *(const PG8_LAS bf16x8*)(lds + PG8_SB(b, h) + boff + n * 2048 + k * 1024); } while (0)
#define PG8_MMA(ai, bj, At, Bt) do { __builtin_amdgcn_s_setprio(1); _Pragma("unroll") for (int m = 0; m < 4; ++m) _Pragma("unroll") for (int n = 0; n < 2; ++n) _Pragma("unroll") for (int k = 0; k < 2; ++k) \
        acc[ai][bj][m][n] = __builtin_amdgcn_mfma_f32_16x16x32_bf16(Bt[n][k], At[m][k], acc[ai][bj][m][n], 0, 0, 0); __builtin_amdgcn_s_setprio(0); } while (0)
#define PG8_WAIT_V(n) asm volatile("s_waitcnt vmcnt(" #n ")" ::: "memory")
#define PG8_WAIT_L(n) asm volatile("s_waitcnt lgkmcnt(" #n ")" ::: "memory")
#define PG8_BAR __builtin_amdgcn_s_barrier()
#define PG8_SCHED __builtin_amdgcn_sched_barrier(0)
    Unit cur, nxt; int ui = 0;
    if (!S.next(0, cur)) return;
    f32x4 acc[2][2][4][2];
#pragma unroll
    for (int a = 0; a < 2; ++a)
#pragma unroll
        for (int b = 0; b < 2; ++b)
#pragma unroll
            for (int m = 0; m < 4; ++m)
#pragma unroll
                for (int n = 0; n < 2; ++n) acc[a][b][m][n] = (f32x4){0.f, 0.f, 0.f, 0.f};
    bf16x8 At[4][2], B0[2][2], B1[2][2];
    const char* cA = (const char*)g.A + (size_t)cur.pm * tstep; const char* cB = (const char*)g.Bt + (size_t)cur.pn * tstep;
    S.a_ready(cur);
    if constexpr (SP2) {
        PG8_STAGE(PG8_SB(0, 0), cB, voffB); PG8_STAGE(PG8_SB(0, 1), cB + hstep, voffB); PG8_STAGE(PG8_SA(0, 0), cA, voffA); PG8_STAGE(PG8_SA(0, 1), cA + hstep, voffA);
        if (wr == 1) PG8_BAR;
        PG8_WAIT_V(2); PG8_BAR;
        PG8_STAGE(PG8_SB(1, 0), cB + kstep, voffB); PG8_STAGE(PG8_SA(1, 0), cA + kstep, voffA); PG8_STAGE(PG8_SB(1, 1), cB + hstep + kstep, voffB);
        PG8_WAIT_V(6); PG8_BAR;
    } else {
        PG8_STAGE(PG8_SB(0, 0), cB, voffB); PG8_STAGE(PG8_SA(0, 0), cA, voffA); PG8_STAGE(PG8_SB(0, 1), cB + hstep, voffB); PG8_STAGE(PG8_SA(0, 1), cA + hstep, voffA);
        if (wr == 1) PG8_BAR;
        PG8_WAIT_V(4); PG8_BAR;
        PG8_STAGE(PG8_SB(1, 0), cB + kstep, voffB); PG8_STAGE(PG8_SA(1, 0), cA + kstep, voffA); PG8_STAGE(PG8_SB(1, 1), cB + hstep + kstep, voffB);
        PG8_WAIT_V(6); PG8_BAR;
    }
    for (;;) {
        const bool has_next = S.next(ui + 1, nxt);
        const char* nA = has_next ? (const char*)g.A + (size_t)nxt.pm * tstep : cA; const char* nB = has_next ? (const char*)g.Bt + (size_t)nxt.pn * tstep : cB;
        for (int t = 0; t < nt; t += 2) {
            const bool last = (t == nt - 2);
            const char* a1 = cA + (size_t)(t + 1) * kstep;
            const char* a2 = last ? nA : cA + (size_t)(t + 2) * kstep; const char* b2 = last ? nB : cB + (size_t)(t + 2) * kstep;
            const char* a3 = a2 + kstep; const char* b3 = b2 + kstep;
            if (last && has_next) S.a_ready(nxt);
            if constexpr (SP2) {
            PG8_LDB(B0, 0, 0); PG8_LDB(B1, 0, 1); PG8_SCHED; PG8_LDA(At, 0, 0); PG8_STAGE(PG8_SA(1, 1), a1 + hstep, voffA);
            PG8_WAIT_V(8); PG8_WAIT_L(0); PG8_BAR; PG8_MMA(0, 0, At, B0); PG8_MMA(0, 1, At, B1); PG8_BAR; PG8_SCHED;
            PG8_LDA(At, 0, 1); PG8_STAGE(PG8_SB(0, 0), b2, voffB); PG8_STAGE(PG8_SB(0, 1), b2 + hstep, voffB); PG8_STAGE(PG8_SA(0, 0), a2, voffA);
            PG8_WAIT_V(8); PG8_WAIT_L(0); PG8_BAR; PG8_MMA(1, 0, At, B0); PG8_MMA(1, 1, At, B1); PG8_BAR; PG8_SCHED;
            PG8_LDB(B0, 1, 0); PG8_LDB(B1, 1, 1); PG8_SCHED; PG8_LDA(At, 1, 0); PG8_STAGE(PG8_SA(0, 1), a2 + hstep, voffA);
            PG8_WAIT_V(8); PG8_WAIT_L(0); PG8_BAR; PG8_MMA(0, 0, At, B0); PG8_MMA(0, 1, At, B1); PG8_BAR; PG8_SCHED;
            PG8_LDA(At, 1, 1); PG8_STAGE(PG8_SB(1, 0), b3, voffB); PG8_STAGE(PG8_SB(1, 1), b3 + hstep, voffB); PG8_STAGE(PG8_SA(1, 0), a3, voffA);
            PG8_WAIT_V(8); PG8_WAIT_L(0); PG8_BAR; PG8_MMA(1, 0, At, B0); PG8_MMA(1, 1, At, B1); PG8_BAR; PG8_SCHED;
            } else {
            PG8_LDB(B0, 0, 0); PG8_SCHED; PG8_LDA(At, 0, 0); PG8_STAGE(PG8_SA(1, 1), a1 + hstep, voffA);
            PG8_WAIT_L(8); PG8_BAR; PG8_WAIT_L(0); PG8_MMA(0, 0, At, B0); PG8_BAR; PG8_SCHED;
            PG8_LDB(B1, 0, 1); PG8_STAGE(PG8_SB(0, 0), b2, voffB);
            PG8_BAR; PG8_WAIT_L(0); PG8_MMA(0, 1, At, B1); PG8_BAR;
            PG8_LDA(At, 0, 1); PG8_STAGE(PG8_SA(0, 0), a2, voffA);
            PG8_BAR; PG8_WAIT_L(0); PG8_MMA(1, 0, At, B0); PG8_BAR; PG8_SCHED;
            PG8_STAGE(PG8_SB(0, 1), b2 + hstep, voffB);
            PG8_WAIT_V(6); PG8_BAR; PG8_MMA(1, 1, At, B1); PG8_BAR;
            PG8_LDB(B0, 1, 0); PG8_SCHED; PG8_LDA(At, 1, 0); PG8_STAGE(PG8_SA(0, 1), a2 + hstep, voffA);
            PG8_WAIT_L(8); PG8_BAR; PG8_WAIT_L(0); PG8_MMA(0, 0, At, B0); PG8_BAR; PG8_SCHED;
            PG8_LDB(B1, 1, 1); PG8_STAGE(PG8_SB(1, 0), b3, voffB);
            PG8_BAR; PG8_WAIT_L(0); PG8_MMA(0, 1, At, B1); PG8_BAR;
            PG8_LDA(At, 1, 1); PG8_STAGE(PG8_SA(1, 0), a3, voffA);
            PG8_BAR; PG8_WAIT_L(0); PG8_MMA(1, 0, At, B0); PG8_BAR; PG8_SCHED;
            PG8_STAGE(PG8_SB(1, 1), b3 + hstep, voffB);
            PG8_WAIT_V(6); PG8_BAR; PG8_MMA(1, 1, At, B1); PG8_BAR;
            }
        }
        if constexpr (ALIGN_EPI) { if (wr == 0) PG8_BAR; }
        if constexpr (!Epi::AFTER_DRAIN) { E(acc, cur, wr, wc, fr, fq); S.done(cur); }
        if (!has_next) break;
#pragma unroll
        for (int a = 0; a < 2; ++a)
#pragma unroll
            for (int b = 0; b < 2; ++b)
#pragma unroll
                for (int m = 0; m < 4; ++m)
#pragma unroll
                    for (int n = 0; n < 2; ++n) acc[a][b][m][n] = (f32x4){0.f, 0.f, 0.f, 0.f};
        cur = nxt; cA = nA; cB = nB; ++ui;
        if constexpr (ALIGN_EPI) { if (wr == 1) PG8_BAR; }
    }
    PG8_WAIT_V(0);
    if constexpr (!ALIGN_EPI) { if (wr == 0) PG8_BAR; }
    PG8_BAR;
    if constexpr (Epi::AFTER_DRAIN) { E.fused(acc, cur, wr, wc, fr, fq, lds, wid, lane); S.done(cur); }
#undef PG8_SA
#undef PG8_SB
#undef PG8_STAGE
#undef PG8_LDA
#undef PG8_LDB
#undef PG8_MMA
#undef PG8_WAIT_V
#undef PG8_WAIT_L
#undef PG8_BAR
#undef PG8_SCHED
}
}

#ifndef PG8_SP2
#define PG8_SP2 true
#endif
#ifndef PG8_ALIGN
#define PG8_ALIGN true
#endif
#include <hip/hip_cooperative_groups.h>
namespace cg = cooperative_groups;

#define LAS __attribute__((address_space(3)))
typedef unsigned short bf16;
typedef unsigned v4u __attribute__((ext_vector_type(4)));
typedef unsigned v2u __attribute__((ext_vector_type(2)));
typedef float f32x4 __attribute__((ext_vector_type(4)));
typedef short bf16x8 __attribute__((ext_vector_type(8)));

constexpr int NWAVES = 8, NTHREADS = 512;
constexpr int SEQ = 8192, M = 16384, D = 1024, FF = 4096, NMAIN = 3840, NVA = 512, NIN = 4352;
constexpr float LN_EPS = 1e-5f;
constexpr float ALPHA = 1.189207115002721f;
constexpr size_t MiB = 1u << 20;
constexpr size_t WS_STATS = 0, WS_CS = 256 * 1024;
constexpr size_t WS_WIN = 1 * MiB;
constexpr size_t WS_WBNA = 10 * MiB, WS_WBSWA = 11 * MiB, WS_WOUT = 12 * MiB, WS_W1 = 14 * MiB, WS_W2 = 22 * MiB;
constexpr size_t WS_XN = 32 * MiB;
constexpr size_t WS_QA = 64 * MiB, WS_QB = 80 * MiB, WS_KA = 96 * MiB, WS_VAT = 112 * MiB, WS_KB = 128 * MiB, WS_VBT = 132 * MiB, WS_GA = 136 * MiB, WS_GB = 168 * MiB;
constexpr size_t WS_MIX = 96 * MiB;
constexpr size_t WS_U = 64 * MiB;
constexpr size_t WS_ONA = 200 * MiB, WS_OSWA = 216 * MiB;
constexpr size_t WS_BAR = 240 * MiB, BAR_BYTES = 16384;
constexpr size_t WS_END = 241 * MiB;
constexpr int LDS_BYTES = 149632;

__device__ __forceinline__ float bf2f(unsigned h) { return __uint_as_float(h << 16); }
__device__ __forceinline__ unsigned pk2(float lo, float hi) { return pg8::cvt_pk_bf16(lo, hi); }
__device__ __forceinline__ float wave_sum(float v) {
#pragma unroll
    for (int o = 1; o < 64; o <<= 1) v += __shfl_xor(v, o);
    return v;
}
__device__ __forceinline__ f32x4 mfma16(bf16x8 a, bf16x8 b, f32x4 c) { return __builtin_amdgcn_mfma_f32_16x16x32_bf16(a, b, c, 0, 0, 0); }

__device__ __forceinline__ void transpose_item(const float* W, int K, int N, bf16* WT, int k0, int n0, int drow0, LAS float* scr, int lane) {
#pragma unroll 8
    for (int i = 0; i < 32; ++i) { const int kk = 2 * i + (lane >> 5); scr[kk * 33 + (lane & 31)] = W[(size_t)(k0 + kk) * N + n0 + (lane & 31)]; }
    asm volatile("s_waitcnt lgkmcnt(0)" ::: "memory");
    const int c = lane & 7;
#pragma unroll
    for (int j = 0; j < 4; ++j) { const int n = (lane >> 3) + 8 * j; const LAS float* s = scr + (8 * c) * 33 + n;
        v4u o; o.x = pk2(s[0 * 33], s[1 * 33]); o.y = pk2(s[2 * 33], s[3 * 33]); o.z = pk2(s[4 * 33], s[5 * 33]); o.w = pk2(s[6 * 33], s[7 * 33]);
        *(v4u*)(WT + (size_t)(drow0 + n) * K + k0 + 8 * c) = o; }
    asm volatile("s_waitcnt lgkmcnt(0)" ::: "memory");
}
template <bool WF32, bool WBF, bool WST>
__device__ __forceinline__ void ln_row(const float* xrow, const float* g, const float* b, float* of32, bf16* obf, float* stats, int lane) {
    const f32x4* xr = (const f32x4*)xrow + lane;
    f32x4 v[4]; float s = 0.f;
#pragma unroll
    for (int j = 0; j < 4; ++j) { v[j] = xr[64 * j]; s += (v[j].x + v[j].y) + (v[j].z + v[j].w); }
    const float mean = wave_sum(s) * (1.f / D); float s2 = 0.f;
#pragma unroll
    for (int j = 0; j < 4; ++j) { v[j] = v[j] - mean; s2 += (v[j].x * v[j].x + v[j].y * v[j].y) + (v[j].z * v[j].z + v[j].w * v[j].w); }
    const float rstd = 1.f / sqrtf(wave_sum(s2) * (1.f / D) + LN_EPS);
    if (WST) { if (lane == 0) { stats[0] = mean; stats[1] = rstd; } }
#pragma unroll
    for (int j = 0; j < 4; ++j) {
        const f32x4 gv = *((const f32x4*)g + lane + 64 * j), bv = *((const f32x4*)b + lane + 64 * j);
        const f32x4 y = v[j] * rstd * gv + bv;
        if (WF32) *((f32x4*)of32 + lane + 64 * j) = y;
        if (WBF) { v2u o; o.x = pk2(y.x, y.y); o.y = pk2(y.z, y.w); *((v2u*)obf + lane + 64 * j) = o; }
    }
}

struct EpiProj {
    static constexpr bool PERM = true, AFTER_DRAIN = false;
    bf16 *QA, *KA, *QB, *KB, *VBT, *GA, *GB; const float* bias; const float* cs;
    __device__ __forceinline__ void operator()(const f32x4 (&acc)[2][2][4][2], const pg8::Unit& u, int wr, int wc, int fr, int fq) const {
        const int row0 = u.pm * 256 + wr * 64 + fr;
#pragma unroll
        for (int bj = 0; bj < 2; ++bj) {
            const int cb = u.pn * 256 + bj * 128;
            const int c = cb + wc * 32 + 8 * fq;
            const int src = c < 1024 ? c : c + 512;
            const f32x4 b0 = *(const f32x4*)(bias + src), b1 = *(const f32x4*)(bias + src + 4);
            int kind; bf16* dst; int ld, coff;
            if (cb < 512) { kind = 0; dst = QA; ld = 512; coff = c; }
            else if (cb < 1024) { kind = 1; dst = KA; ld = 512; coff = c - 512; }
            else if (cb < 1536) { kind = 2; dst = QB; ld = 512; coff = c - 1024; }
            else if (cb < 1664) { kind = 3; dst = KB; ld = 128; coff = c - 1536; }
            else if (cb < 1792) { kind = 4; dst = VBT; ld = 0; coff = c - 1664; }
            else if (cb < 2816) { kind = 5; dst = GA; ld = 1024; coff = c - 1792; }
            else { kind = 5; dst = GB; ld = 1024; coff = c - 2816; }
            const bool rot = (kind == 2 || kind == 3) && ((wc & 1) == 0);
#pragma unroll
            for (int ai = 0; ai < 2; ++ai)
#pragma unroll
                for (int m = 0; m < 4; ++m) {
                    const int row = row0 + ai * 128 + m * 16;
                    f32x4 v0 = acc[ai][bj][m][0] + b0, v1 = acc[ai][bj][m][1] + b1;
                    if (rot) {
                        const float* t = cs + (size_t)(row & (SEQ - 1)) * 16;
                        const f32x4 c0 = *(const f32x4*)t, c1 = *(const f32x4*)(t + 4), s0 = *(const f32x4*)(t + 8), s1 = *(const f32x4*)(t + 12);
                        f32x4 p0, p1;
#pragma unroll
                        for (int e = 0; e < 4; ++e) { p0[e] = __shfl_xor(v0[e], 16); p1[e] = __shfl_xor(v1[e], 16); }
                        const float sg = (fq == 0) ? -1.f : 1.f;
                        if (fq < 2) { v0 = v0 * c0 + (p0 * sg) * s0; v1 = v1 * c1 + (p1 * sg) * s1; }
                    }
                    if (kind == 0 || kind == 2) { v0 = v0 * 0.125f; v1 = v1 * 0.125f; }
                    if (kind == 5) {
#pragma unroll
                        for (int e = 0; e < 4; ++e) { v0[e] = 1.f / (1.f + __expf(-v0[e])); v1[e] = 1.f / (1.f + __expf(-v1[e])); }
                    }
                    if (kind == 4) {
#pragma unroll
                        for (int e = 0; e < 4; ++e) { dst[(size_t)(coff + e) * M + row] = (bf16)(pk2(v0[e], 0.f) & 0xffffu); dst[(size_t)(coff + 4 + e) * M + row] = (bf16)(pk2(v1[e], 0.f) & 0xffffu); }
                    } else {
                        v4u w; w.x = pk2(v0[0], v0[1]); w.y = pk2(v0[2], v0[3]); w.z = pk2(v1[0], v1[1]); w.w = pk2(v1[2], v1[3]);
                        *(v4u*)(dst + (size_t)row * ld + coff) = w;
                    }
                }
        }
    }
};
struct EpiVT {
    static constexpr bool PERM = true, AFTER_DRAIN = false;
    bf16* VAT; const float* bias;
    __device__ __forceinline__ void operator()(const f32x4 (&acc)[2][2][4][2], const pg8::Unit& u, int wr, int wc, int fr, int fq) const {
        const int row0 = u.pm * 256 + wr * 64 + fr, col0 = u.pn * 256 + wc * 32 + 8 * fq;
#pragma unroll
        for (int ai = 0; ai < 2; ++ai)
#pragma unroll
            for (int m = 0; m < 4; ++m) { const int row = row0 + ai * 128 + m * 16; const float b = bias[row];
#pragma unroll
                for (int bj = 0; bj < 2; ++bj) { const f32x4 v0 = acc[ai][bj][m][0] + b, v1 = acc[ai][bj][m][1] + b;
                    v4u w; w.x = pk2(v0[0], v0[1]); w.y = pk2(v0[2], v0[3]); w.z = pk2(v1[0], v1[1]); w.w = pk2(v1[2], v1[3]);
                    *(v4u*)(VAT + (size_t)row * M + col0 + bj * 128) = w; } }
    }
};
template <int MODE> struct EpiGate {
    static constexpr bool PERM = true, AFTER_DRAIN = false;
    bf16* T; const bf16* G;
    __device__ __forceinline__ void operator()(const f32x4 (&acc)[2][2][4][2], const pg8::Unit& u, int wr, int wc, int fr, int fq) const {
        const int row0 = u.pm * 256 + wr * 64 + fr, col0 = u.pn * 256 + wc * 32 + 8 * fq;
#pragma unroll
        for (int ai = 0; ai < 2; ++ai)
#pragma unroll
            for (int m = 0; m < 4; ++m)
#pragma unroll
                for (int bj = 0; bj < 2; ++bj) {
                    const size_t off = (size_t)(row0 + ai * 128 + m * 16) * D + col0 + bj * 128;
                    const v4u gw = *(const v4u*)(G + off);
                    float r[8];
                    const f32x4 a0 = acc[ai][bj][m][0], a1 = acc[ai][bj][m][1];
                    r[0] = bf2f(gw.x & 0xffffu) * a0[0]; r[1] = bf2f(gw.x >> 16) * a0[1]; r[2] = bf2f(gw.y & 0xffffu) * a0[2]; r[3] = bf2f(gw.y >> 16) * a0[3];
                    r[4] = bf2f(gw.z & 0xffffu) * a1[0]; r[5] = bf2f(gw.z >> 16) * a1[1]; r[6] = bf2f(gw.w & 0xffffu) * a1[2]; r[7] = bf2f(gw.w >> 16) * a1[3];
                    if (MODE == 1) { const v4u tw = *(const v4u*)(T + off);
                        r[0] += bf2f(tw.x & 0xffffu); r[1] += bf2f(tw.x >> 16); r[2] += bf2f(tw.y & 0xffffu); r[3] += bf2f(tw.y >> 16);
                        r[4] += bf2f(tw.z & 0xffffu); r[5] += bf2f(tw.z >> 16); r[6] += bf2f(tw.w & 0xffffu); r[7] += bf2f(tw.w >> 16); }
                    v4u w; w.x = pk2(r[0], r[1]); w.y = pk2(r[2], r[3]); w.z = pk2(r[4], r[5]); w.w = pk2(r[6], r[7]);
                    *(v4u*)(T + off) = w;
                }
    }
};
struct EpiZ1 {
    static constexpr bool PERM = false, AFTER_DRAIN = false;
    float* Z; const float* x; const float* stats; const float* g0; const float* b0; const float* bias;
    __device__ __forceinline__ void operator()(const f32x4 (&acc)[2][2][4][2], const pg8::Unit& u, int wr, int wc, int fr, int fq) const {
        const int row0 = u.pm * 256 + wr * 64 + fr, col0 = u.pn * 256 + wc * 32 + 4 * fq;
#pragma unroll
        for (int ai = 0; ai < 2; ++ai)
#pragma unroll
            for (int m = 0; m < 4; ++m) { const int row = row0 + ai * 128 + m * 16; const float mean = stats[2 * row], rstd = stats[2 * row + 1];
#pragma unroll
                for (int bj = 0; bj < 2; ++bj)
#pragma unroll
                    for (int n = 0; n < 2; ++n) { const int col = col0 + bj * 128 + n * 16; const size_t off = (size_t)row * D + col;
                        const f32x4 xv = *(const f32x4*)(x + off), gv = *(const f32x4*)(g0 + col), bv = *(const f32x4*)(b0 + col), bb = *(const f32x4*)(bias + col);
                        const f32x4 h0 = (xv - mean) * rstd * gv + bv;
                        *(f32x4*)(Z + off) = acc[ai][bj][m][n] + bb + h0 * ALPHA; } }
    }
};
struct EpiFf1 {
    static constexpr bool PERM = true, AFTER_DRAIN = false;
    bf16* U; const float* bias;
    __device__ __forceinline__ void operator()(const f32x4 (&acc)[2][2][4][2], const pg8::Unit& u, int wr, int wc, int fr, int fq) const {
        const int row0 = u.pm * 256 + wr * 64 + fr, col0 = u.pn * 256 + wc * 32 + 8 * fq;
#pragma unroll
        for (int bj = 0; bj < 2; ++bj) { const f32x4 b0 = *(const f32x4*)(bias + col0 + bj * 128), b1 = *(const f32x4*)(bias + col0 + bj * 128 + 4);
#pragma unroll
            for (int ai = 0; ai < 2; ++ai)
#pragma unroll
                for (int m = 0; m < 4; ++m) { f32x4 v0 = acc[ai][bj][m][0] + b0, v1 = acc[ai][bj][m][1] + b1;
#pragma unroll
                    for (int e = 0; e < 4; ++e) { const float a = fmaxf(v0[e], 0.f), b = fmaxf(v1[e], 0.f); v0[e] = a * a; v1[e] = b * b; }
                    v4u w; w.x = pk2(v0[0], v0[1]); w.y = pk2(v0[2], v0[3]); w.z = pk2(v1[0], v1[1]); w.w = pk2(v1[2], v1[3]);
                    *(v4u*)(U + (size_t)(row0 + ai * 128 + m * 16) * FF + col0 + bj * 128) = w; } }
    }
};
struct EpiZ2 {
    static constexpr bool PERM = false, AFTER_DRAIN = false;
    float* Z; const float* bias;
    __device__ __forceinline__ void operator()(const f32x4 (&acc)[2][2][4][2], const pg8::Unit& u, int wr, int wc, int fr, int fq) const {
        const int row0 = u.pm * 256 + wr * 64 + fr, col0 = u.pn * 256 + wc * 32 + 4 * fq;
#pragma unroll
        for (int ai = 0; ai < 2; ++ai)
#pragma unroll
            for (int m = 0; m < 4; ++m) { const int row = row0 + ai * 128 + m * 16;
#pragma unroll
                for (int bj = 0; bj < 2; ++bj)
#pragma unroll
                    for (int n = 0; n < 2; ++n) { const int col = col0 + bj * 128 + n * 16; const size_t off = (size_t)row * D + col;
                        const f32x4 hv = *(const f32x4*)(Z + off), bb = *(const f32x4*)(bias + col);
                        *(f32x4*)(Z + off) = acc[ai][bj][m][n] + bb + hv * ALPHA; } }
    }
};

constexpr float L2E = 1.4426950408889634f;
constexpr int NA_K_OFF = 0, NA_V_OFF = 73728, NA_RPB_OFF = 147456;
constexpr int SW_K_OFF = 0, SW_V_OFF = 49152, SW_VROW = 784;
constexpr int MISC_OFF = 149376;
__device__ __forceinline__ void na_block(const bf16* QA, const bf16* KA, const bf16* VAT, bf16* O, const float* rpbg, LAS unsigned char* lds, int u, int tid, int lane, int wave) {
    const int b = u >> 9, h = (u >> 6) & 7, rp = u & 63;
    const int R0 = min(max(2 * rp - 4, 0), 120);
    const size_t tokb = (size_t)b * SEQ;
    __syncthreads();
    LAS float* rpb = (LAS float*)(lds + NA_RPB_OFF);
    if (tid < 465) rpb[tid] = rpbg[h * 465 + tid];
    v4u kreg[9], vreg[9];
#pragma unroll
    for (int i = 0; i < 9; ++i) { const int ci = i * 512 + tid, key = ci >> 3, c = (ci & 7) ^ ((key >> 1) & 7);
        const int tok = min(R0 * 64 + key, SEQ - 1);
        kreg[i] = *(const v4u*)(KA + (tokb + tok) * 512 + h * 64 + c * 8); }
#pragma unroll
    for (int i = 0; i < 9; ++i) { const int ci = i * 512 + tid, row = ci >> 3, c = (ci & 7) ^ ((row >> 1) & 7);
        const int grow = min(R0 + (row >> 6), 127), d = row & 63;
        vreg[i] = *(const v4u*)(VAT + (size_t)(h * 64 + d) * M + tokb + grow * 64 + c * 8); }
    const int n = lane & 15, rq = lane >> 4;
    const int r = 2 * rp + (wave >> 2), cb = wave & 3;
    const int rs = min(max(r - 4, 0), 120), kro = rs - R0;
    const int kc0 = cb == 0 ? 0 : cb == 1 ? 8 : cb == 2 ? 24 : 32;
    const size_t qtok = tokb + r * 64 + cb * 16 + n;
    const bf16* qp = QA + qtok * 512 + h * 64 + rq * 8;
    const bf16x8 q0 = *(const bf16x8*)qp, q1 = *(const bf16x8*)(qp + 32);
#pragma unroll
    for (int i = 0; i < 9; ++i) *(LAS v4u*)(lds + NA_K_OFF + (i * 512 + tid) * 16) = kreg[i];
    __syncthreads();
    f32x4 s[16];
    {
        const int fsw = ((kc0 >> 1) + (n >> 1)) & 7;
        const LAS unsigned char* kp = lds + NA_K_OFF + (kro * 64 + kc0 + n) * 128;
        const int off0 = (rq ^ fsw) * 16, off1 = ((rq + 4) ^ fsw) * 16;
#pragma unroll
        for (int jb = 0; jb < 16; ++jb) {
            const LAS unsigned char* base = kp + ((jb >> 1) * 64 + (jb & 1) * 16) * 128;
            const bf16x8 k0 = *(const LAS bf16x8*)(base + off0), k1 = *(const LAS bf16x8*)(base + off1);
            f32x4 a = {0.f, 0.f, 0.f, 0.f};
            a = mfma16(k0, q0, a); a = mfma16(k1, q1, a); s[jb] = a;
        }
    }
    const int c = 16 * cb + n, cs = min(max(c - 8, 0), 48);
    float mx = -1e30f;
#pragma unroll
    for (int jb = 0; jb < 16; ++jb) {
        const int kr = jb >> 1, half = jb & 1;
        const LAS float* rpr = rpb + ((rs + kr - r) + 7) * 31;
#pragma unroll
        for (int e = 0; e < 4; ++e) {
            const int kc = kc0 + 16 * half + 4 * rq + e;
            const bool valid = (kc >= cs) && (kc < cs + 16);
            const int idx = min(max(kc - c + 15, 0), 30);
            const float v = valid ? s[jb][e] + rpr[idx] : -1e30f;
            s[jb][e] = v; mx = fmaxf(mx, v);
        }
    }
    mx = fmaxf(mx, __shfl_xor(mx, 16)); mx = fmaxf(mx, __shfl_xor(mx, 32));
    float sum = 0.f;
#pragma unroll
    for (int jb = 0; jb < 16; ++jb)
#pragma unroll
        for (int e = 0; e < 4; ++e) { const float p = __builtin_amdgcn_exp2f((s[jb][e] - mx) * L2E); s[jb][e] = p; sum += p; }
    sum += __shfl_xor(sum, 16); sum += __shfl_xor(sum, 32);
    const float inv = 1.f / sum;
#pragma unroll
    for (int i = 0; i < 9; ++i) *(LAS v4u*)(lds + NA_V_OFF + (i * 512 + tid) * 16) = vreg[i];
    __syncthreads();
    f32x4 o[4];
#pragma unroll
    for (int dt = 0; dt < 4; ++dt) o[dt] = (f32x4){0.f, 0.f, 0.f, 0.f};
    {
        const int fv2 = 2 * ((n >> 1) & 7), g0 = (kc0 >> 2) + rq;
        const int voff0 = (g0 ^ fv2) * 8, voff1 = ((g0 + 4) ^ fv2) * 8;
        const LAS unsigned char* vp = lds + NA_V_OFF + (kro * 64 + n) * 128;
#pragma unroll
        for (int kr = 0; kr < 8; ++kr) {
            v4u pw; pw.x = pk2(s[2 * kr][0], s[2 * kr][1]); pw.y = pk2(s[2 * kr][2], s[2 * kr][3]); pw.z = pk2(s[2 * kr + 1][0], s[2 * kr + 1][1]); pw.w = pk2(s[2 * kr + 1][2], s[2 * kr + 1][3]);
            const bf16x8 pb = __builtin_bit_cast(bf16x8, pw);
#pragma unroll
            for (int dt = 0; dt < 4; ++dt) {
                const LAS unsigned char* base = vp + (kr * 64 + dt * 16) * 128;
                const v2u lo = *(const LAS v2u*)(base + voff0), hi = *(const LAS v2u*)(base + voff1);
                v4u vw; vw.x = lo.x; vw.y = lo.y; vw.z = hi.x; vw.w = hi.y;
                o[dt] = mfma16(__builtin_bit_cast(bf16x8, vw), pb, o[dt]);
            }
        }
    }
    bf16* op = O + qtok * 512 + h * 64 + 4 * rq;
#pragma unroll
    for (int dt = 0; dt < 4; ++dt) { v2u w; w.x = pk2(o[dt][0] * inv, o[dt][1] * inv); w.y = pk2(o[dt][2] * inv, o[dt][3] * inv); *(v2u*)(op + dt * 16) = w; }
}
__device__ __forceinline__ void swa_block(const bf16* QB, const bf16* KB, const bf16* VBT, bf16* O, const float* sink, LAS unsigned char* lds, int u, int tid, int lane, int wave) {
    const int b = u >> 7, g = (u >> 6) & 1, qblk = u & 63, i0 = qblk * 128, t0 = i0 - 128;
    const size_t tokb = (size_t)b * SEQ;
    __syncthreads();
    {
        v4u kreg[6], vreg[6];
#pragma unroll
        for (int i = 0; i < 6; ++i) { const int ci = i * 512 + tid, key = ci >> 3, c = (ci & 7) ^ ((key >> 1) & 7);
            const int tok = min(max(t0 + key, 0), SEQ - 1);
            kreg[i] = *(const v4u*)(KB + (tokb + tok) * 128 + g * 64 + c * 8); }
#pragma unroll
        for (int i = 0; i < 6; ++i) { const int ci = i * 512 + tid, d = ci / 48, c = ci - d * 48;
            const int tk = min(max(t0 + 8 * c, 0), SEQ - 8);
            vreg[i] = *(const v4u*)(VBT + (size_t)(g * 64 + d) * M + tokb + tk); }
#pragma unroll
        for (int i = 0; i < 6; ++i) *(LAS v4u*)(lds + SW_K_OFF + (i * 512 + tid) * 16) = kreg[i];
#pragma unroll
        for (int i = 0; i < 6; ++i) { const int ci = i * 512 + tid, d = ci / 48, c = ci - d * 48; *(LAS v4u*)(lds + SW_V_OFF + d * SW_VROW + c * 16) = vreg[i]; }
    }
    __syncthreads();
    const int n = lane & 15, rq = lane >> 4, hq = g * 4 + (wave & 3);
    const float sk = sink[hq];
    const int fsw = (n >> 1) & 7, off0 = (rq ^ fsw) * 16, off1 = ((rq + 4) ^ fsw) * 16;
#pragma unroll 1
    for (int j = 0; j < 4; ++j) {
        const int sb = (wave >> 2) * 4 + j, i0s = i0 + 16 * sb;
        const size_t qtok = tokb + i0s + n;
        const bf16* qp = QB + qtok * 512 + hq * 64 + rq * 8;
        const bf16x8 q0 = *(const bf16x8*)qp, q1 = *(const bf16x8*)(qp + 32);
        f32x4 s[18];
        const LAS unsigned char* kp = lds + SW_K_OFF + (16 * sb + n) * 128;
#pragma unroll
        for (int jb = 0; jb < 17; ++jb) {
            const LAS unsigned char* base = kp + jb * 16 * 128;
            const bf16x8 k0 = *(const LAS bf16x8*)(base + off0), k1 = *(const LAS bf16x8*)(base + off1);
            f32x4 a = {0.f, 0.f, 0.f, 0.f};
            a = mfma16(k0, q0, a); a = mfma16(k1, q1, a); s[jb] = a;
        }
        s[17] = (f32x4){0.f, 0.f, 0.f, 0.f};
        float mx = sk;
#pragma unroll
        for (int jb = 0; jb < 17; ++jb)
#pragma unroll
            for (int e = 0; e < 4; ++e) {
                const int rel = 16 * jb - 128 + 4 * rq + e - n, kpos = i0s + n + rel;
                const bool valid = (kpos >= 0) && (kpos < SEQ) && (rel >= -128) && (rel <= 128);
                const float v = valid ? s[jb][e] : -1e30f;
                s[jb][e] = v; mx = fmaxf(mx, v);
            }
        mx = fmaxf(mx, __shfl_xor(mx, 16)); mx = fmaxf(mx, __shfl_xor(mx, 32));
        float sum = 0.f;
#pragma unroll
        for (int jb = 0; jb < 17; ++jb)
#pragma unroll
            for (int e = 0; e < 4; ++e) { const float p = __builtin_amdgcn_exp2f((s[jb][e] - mx) * L2E); s[jb][e] = p; sum += p; }
        sum += __shfl_xor(sum, 16); sum += __shfl_xor(sum, 32);
        sum += __builtin_amdgcn_exp2f((sk - mx) * L2E);
        const float inv = 1.f / sum;
        f32x4 o[4];
#pragma unroll
        for (int dt = 0; dt < 4; ++dt) o[dt] = (f32x4){0.f, 0.f, 0.f, 0.f};
        const LAS unsigned char* vp = lds + SW_V_OFF + n * SW_VROW + sb * 32 + rq * 8;
#pragma unroll
        for (int ks = 0; ks < 9; ++ks) {
            v4u pw; pw.x = pk2(s[2 * ks][0], s[2 * ks][1]); pw.y = pk2(s[2 * ks][2], s[2 * ks][3]); pw.z = pk2(s[2 * ks + 1][0], s[2 * ks + 1][1]); pw.w = pk2(s[2 * ks + 1][2], s[2 * ks + 1][3]);
            const bf16x8 pb = __builtin_bit_cast(bf16x8, pw);
            const int jb1 = (2 * ks + 1 < 17) ? 2 * ks + 1 : 16;
#pragma unroll
            for (int dt = 0; dt < 4; ++dt) {
                const LAS unsigned char* base = vp + dt * 16 * SW_VROW;
                const v2u lo = *(const LAS v2u*)(base + 2 * ks * 32), hi = *(const LAS v2u*)(base + jb1 * 32);
                v4u vw; vw.x = lo.x; vw.y = lo.y; vw.z = hi.x; vw.w = hi.y;
                o[dt] = mfma16(__builtin_bit_cast(bf16x8, vw), pb, o[dt]);
            }
        }
        bf16* op = O + qtok * 512 + hq * 64 + 4 * rq;
#pragma unroll
        for (int dt = 0; dt < 4; ++dt) { v2u w; w.x = pk2(o[dt][0] * inv, o[dt][1] * inv); w.y = pk2(o[dt][2] * inv, o[dt][3] * inv); *(v2u*)(op + dt * 16) = w; }
    }
}

#define XB_TMO      128
#define XB_XCNT(j)  (256  + 64 * (j))
#define XB_XSUB(j)  (1280 + 64 * (j))
#define XB_XGEN(j)  (2304 + 64 * (j))
#define XB_TOP      3328
#define XB_TOPGEN   3392
#define XCD_BAR_WORDS 3456
#define XB_SPIN_CAP (1u << 18)

__device__ __forceinline__ unsigned xb_ld(unsigned* p)              { return __hip_atomic_load(p, __ATOMIC_RELAXED, __HIP_MEMORY_SCOPE_AGENT); }
__device__ __forceinline__ unsigned xb_add(unsigned* p, unsigned v) { return __hip_atomic_fetch_add(p, v, __ATOMIC_RELAXED, __HIP_MEMORY_SCOPE_AGENT); }
__device__ __forceinline__ unsigned xb_xcc_id() { return (unsigned)__builtin_amdgcn_s_getreg((3 << 11) | 20) & 0xFu; }
#define XB_SPIN(cond, bar) do { unsigned _sp = 0; while (cond) { __builtin_amdgcn_s_sleep(1); \
    if ((++_sp & 255u) == 0u) { if (xb_ld(&(bar)[XB_TMO])) break; if (_sp > XB_SPIN_CAP) { atomicAdd(&(bar)[XB_TMO], 1u); break; } } } } while (0)

struct XcdBarrier {
    unsigned* bar; unsigned x;
    volatile LAS unsigned* st;
};

__device__ __forceinline__ XcdBarrier xcd_barrier_post(unsigned* bar, volatile LAS unsigned* st) {
    XcdBarrier b; b.bar = bar; b.x = xb_xcc_id(); b.st = st;
    if (threadIdx.x == 0) (void)xb_add(&bar[XB_XCNT(b.x)], 1u);
    return b;
}
__device__ __forceinline__ void xcd_barrier_complete(unsigned* bar, unsigned x, unsigned& nloc, unsigned& nx) {
    const unsigned G = gridDim.x * gridDim.y * gridDim.z;
    unsigned sum, cnt, mine, sp = 0u;
    for (;;) {
        sum = 0u; cnt = 0u; mine = 0u;
#pragma unroll
        for (unsigned j = 0; j < 16; ++j) { const unsigned c = xb_ld(&bar[XB_XCNT(j)]); sum += c; cnt += (c > 0u) ? 1u : 0u; mine = (j == x) ? c : mine; }
        if (sum == G) break;
        __builtin_amdgcn_s_sleep(1);
        if ((++sp & 255u) == 0u) { if (xb_ld(&bar[XB_TMO])) break; if (sp > XB_SPIN_CAP) { atomicAdd(&bar[XB_TMO], 1u); break; } }
    }
    nloc = mine > 0u ? mine : 1u; nx = cnt > 0u ? cnt : 1u;
}

__device__ __forceinline__ void xcd_barrier(const XcdBarrier& b) {
    asm volatile("s_waitcnt vmcnt(0)" ::: "memory");
    __syncthreads();
    if (threadIdx.x == 0) {
        unsigned* bar = b.bar;
        __builtin_amdgcn_s_waitcnt(0);
        unsigned nloc = b.st[0], nx = b.st[1];
        if (nloc == 0u) { xcd_barrier_complete(bar, b.x, nloc, nx); b.st[0] = nloc; b.st[1] = nx; }
        const unsigned old = xb_add(&bar[XB_XSUB(b.x)], 1u);
        const unsigned gen = old / nloc;
        if (old + 1u == (gen + 1u) * nloc) {
            __builtin_amdgcn_fence(__ATOMIC_RELEASE, "agent");
            asm volatile("s_waitcnt vmcnt(0)" ::: "memory");
            const unsigned og = xb_add(&bar[XB_TOP], 1u);
            const unsigned tg = og / nx;
            if (og + 1u == (tg + 1u) * nx) xb_add(&bar[XB_TOPGEN], 1u);
            else XB_SPIN(xb_ld(&bar[XB_TOPGEN]) == tg, bar);
            __builtin_amdgcn_fence(__ATOMIC_ACQUIRE, "agent");
            xb_add(&bar[XB_XGEN(b.x)], 1u);
            asm volatile("s_waitcnt vmcnt(0)" ::: "memory");
        } else {
            XB_SPIN(xb_ld(&bar[XB_XGEN(b.x)]) == gen, bar);
            __builtin_amdgcn_fence(__ATOMIC_ACQUIRE, "agent");
            asm volatile("s_waitcnt vmcnt(0)" ::: "memory");
        }
    }
    __syncthreads();
}

#ifndef CG_SYNC_AT_START
#define CG_SYNC_AT_START 0
#endif
#ifndef SYNC_REP
#define SYNC_REP 1
#endif
#ifndef P0_REP
#define P0_REP 1
#endif
#ifndef P1_REP
#define P1_REP 1
#endif
#ifndef P3_REP
#define P3_REP 1
#endif
#ifndef P4_REP
#define P4_REP 1
#endif
#ifndef P5_REP
#define P5_REP 1
#endif
#ifndef ATT_REP
#define ATT_REP 1
#endif
struct Args { const float* in[19]; float* out; unsigned char* ws; int naive; int pad; };
enum { I_X = 0, I_LN0G, I_LN0B, I_WIN, I_BIN, I_RPB, I_SINK, I_WBNA, I_WBSWA, I_WOUT, I_BOUT, I_LN1G, I_LN1B, I_W1, I_B1, I_W2, I_B2, I_LN2G, I_LN2B };

__global__ void __launch_bounds__(NTHREADS, 2) fwd_kernel(Args a) {
    extern __shared__ __attribute__((aligned(16))) unsigned char lds_raw[];
    cg::grid_group grid = cg::this_grid();
    LAS unsigned char* lds = (LAS unsigned char*)lds_raw;
    const int tid = threadIdx.x, lane = tid & 63, wave = __builtin_amdgcn_readfirstlane(tid >> 6);
    const int G = gridDim.x, gw = blockIdx.x * NWAVES + wave, NGW = G * NWAVES;
    unsigned char* ws = a.ws;
    volatile LAS unsigned* MISC = (volatile LAS unsigned*)(lds + MISC_OFF);
    if (tid < 16) MISC[tid] = 0u;
    __syncthreads();
    XcdBarrier bar = xcd_barrier_post((unsigned*)(ws + WS_BAR), MISC + 8);
#if CG_SYNC_AT_START
    grid.sync();
#else
    if (a.pad == 0x5eed) grid.sync();
#endif
    float* stats = (float*)(ws + WS_STATS); float* cs = (float*)(ws + WS_CS);
    bf16* Win_t = (bf16*)(ws + WS_WIN); bf16* Wbna_t = (bf16*)(ws + WS_WBNA); bf16* Wbswa_t = (bf16*)(ws + WS_WBSWA); bf16* Wout_t = (bf16*)(ws + WS_WOUT);
    bf16* W1_t = (bf16*)(ws + WS_W1); bf16* W2_t = (bf16*)(ws + WS_W2);
    bf16* XN = (bf16*)(ws + WS_XN); bf16* QA = (bf16*)(ws + WS_QA); bf16* QB = (bf16*)(ws + WS_QB); bf16* KA = (bf16*)(ws + WS_KA); bf16* VAT = (bf16*)(ws + WS_VAT);
    bf16* KB = (bf16*)(ws + WS_KB); bf16* VBT = (bf16*)(ws + WS_VBT); bf16* GA = (bf16*)(ws + WS_GA); bf16* GB = (bf16*)(ws + WS_GB); bf16* MIX = (bf16*)(ws + WS_MIX); bf16* U = (bf16*)(ws + WS_U); bf16* ONA = (bf16*)(ws + WS_ONA); bf16* OSWA = (bf16*)(ws + WS_OSWA);

    for (int rep_ = 0; rep_ < P0_REP; ++rep_) {
        LAS float* scr = (LAS float*)(lds + wave * 16384);
        constexpr int I_IN = (D / 64) * (NIN / 32), I_BR = (512 / 64) * (D / 32), I_O = (D / 64) * (D / 32), I_1 = (D / 64) * (FF / 32), I_2 = (FF / 64) * (D / 32);
        constexpr int NITEMS = I_IN + 2 * I_BR + I_O + I_1 + I_2;
        for (int it = gw; it < NITEMS; it += NGW) {
            int r = it;
            if (r < I_IN) { const int nblk = NIN / 32, kb = r / nblk, nb = r % nblk, n0 = nb * 32;
                const int drow = n0 < 1024 ? n0 : (n0 < 1536 ? NMAIN + (n0 - 1024) : n0 - 512);
                transpose_item(a.in[I_WIN], D, NIN, Win_t, kb * 64, n0, drow, scr, lane); continue; } r -= I_IN;
            if (r < I_BR) { const int nblk = D / 32; transpose_item(a.in[I_WBNA], 512, D, Wbna_t, (r / nblk) * 64, (r % nblk) * 32, (r % nblk) * 32, scr, lane); continue; } r -= I_BR;
            if (r < I_BR) { const int nblk = D / 32; transpose_item(a.in[I_WBSWA], 512, D, Wbswa_t, (r / nblk) * 64, (r % nblk) * 32, (r % nblk) * 32, scr, lane); continue; } r -= I_BR;
            if (r < I_O) { const int nblk = D / 32; transpose_item(a.in[I_WOUT], D, D, Wout_t, (r / nblk) * 64, (r % nblk) * 32, (r % nblk) * 32, scr, lane); continue; } r -= I_O;
            if (r < I_1) { const int nblk = FF / 32; transpose_item(a.in[I_W1], D, FF, W1_t, (r / nblk) * 64, (r % nblk) * 32, (r % nblk) * 32, scr, lane); continue; } r -= I_1;
            { const int nblk = D / 32; transpose_item(a.in[I_W2], FF, D, W2_t, (r / nblk) * 64, (r % nblk) * 32, (r % nblk) * 32, scr, lane); }
        }
        for (int m = gw; m < M; m += NGW) ln_row<false, true, true>(a.in[I_X] + (size_t)m * D, a.in[I_LN0G], a.in[I_LN0B], nullptr, XN + (size_t)m * D, stats + 2 * m, lane);
        for (int i = blockIdx.x * NTHREADS + tid; i < SEQ * 8; i += G * NTHREADS) {
            const int pos = i >> 3, j = i & 7;
            const float fr = j == 0 ? 1.0f : j == 1 ? 0.19392274f : j == 2 ? 0.03760603f : j == 3 ? 0.0072926646f : j == 4 ? 0.0014142136f : j == 5 ? 0.0002742482f : j == 6 ? 5.3182957e-05f : 1.0313385e-05f;
            const float ang = (float)pos * fr;
            double rv = (double)ang * 0.15915494309189535; rv -= __builtin_rint(rv);
            cs[pos * 16 + j] = __builtin_amdgcn_cosf((float)rv); cs[pos * 16 + 8 + j] = __builtin_amdgcn_sinf((float)rv);
        }
    }
    for (int rep_ = 0; rep_ < SYNC_REP; ++rep_) xcd_barrier(bar);
    for (int rep_ = 0; rep_ < P1_REP; ++rep_) {
        pg8::Gemm g{XN, Win_t, M, NMAIN, D}; pg8::StaticOrder S; S.init(M, NMAIN, G, (int)blockIdx.x);
        EpiProj E{QA, KA, QB, KB, VBT, GA, GB, a.in[I_BIN], cs};
        pg8::gemm_phase<EpiProj, pg8::StaticOrder, PG8_ALIGN, PG8_SP2>(lds, g, S, E);
        pg8::Gemm g2{Win_t + (size_t)NMAIN * D, XN, NVA, M, D}; pg8::StaticOrder S2; S2.init(NVA, M, G, (int)((blockIdx.x + 64) % G));
        EpiVT E2{VAT, a.in[I_BIN] + 1024};
        pg8::gemm_phase<EpiVT, pg8::StaticOrder, PG8_ALIGN, PG8_SP2>(lds, g2, S2, E2);
    }
    for (int rep_ = 0; rep_ < SYNC_REP; ++rep_) xcd_barrier(bar);
    _Pragma("nounroll") for (int rep = 0; rep < ATT_REP; ++rep) {
        const int per = (1024 % G == 0) ? 1024 / G : 0;
        for (int u = blockIdx.x; u < 1024; u += G) { const int uu = per ? (u % G) * per + u / G : u;
            na_block(QA, KA, VAT, ONA, a.in[I_RPB], lds, uu, tid, lane, wave); }
        for (int u = blockIdx.x; u < 256; u += G) swa_block(QB, KB, VBT, OSWA, a.in[I_SINK], lds, u, tid, lane, wave);
        __syncthreads();
    }
    for (int rep_ = 0; rep_ < SYNC_REP; ++rep_) xcd_barrier(bar);
    for (int rep_ = 0; rep_ < P3_REP; ++rep_) {
        pg8::StaticOrder S; S.init(M, D, G, (int)blockIdx.x);
        pg8::Gemm g1{ONA, Wbna_t, M, D, 512}; EpiGate<0> E1{MIX, GA};
        pg8::gemm_phase<EpiGate<0>, pg8::StaticOrder, PG8_ALIGN, PG8_SP2>(lds, g1, S, E1);
        pg8::Gemm g2{OSWA, Wbswa_t, M, D, 512}; EpiGate<1> E2{MIX, GB};
        pg8::gemm_phase<EpiGate<1>, pg8::StaticOrder, PG8_ALIGN, PG8_SP2>(lds, g2, S, E2);
    }
    for (int rep_ = 0; rep_ < SYNC_REP; ++rep_) xcd_barrier(bar);
    for (int rep_ = 0; rep_ < P4_REP; ++rep_) {
        pg8::StaticOrder S; S.init(M, D, G, (int)blockIdx.x);
        pg8::Gemm g{MIX, Wout_t, M, D, D}; EpiZ1 E{a.out, a.in[I_X], stats, a.in[I_LN0G], a.in[I_LN0B], a.in[I_BOUT]};
        pg8::gemm_phase<EpiZ1, pg8::StaticOrder, PG8_ALIGN, PG8_SP2>(lds, g, S, E);
    }
    for (int rep_ = 0; rep_ < SYNC_REP; ++rep_) xcd_barrier(bar);
    for (int m = gw; m < M; m += NGW) ln_row<true, true, false>(a.out + (size_t)m * D, a.in[I_LN1G], a.in[I_LN1B], a.out + (size_t)m * D, XN + (size_t)m * D, nullptr, lane);
    for (int rep_ = 0; rep_ < SYNC_REP; ++rep_) xcd_barrier(bar);
    for (int rep_ = 0; rep_ < P5_REP; ++rep_) {
        pg8::StaticOrder S; S.init(M, FF, G, (int)blockIdx.x);
        pg8::Gemm g{XN, W1_t, M, FF, D}; EpiFf1 E{U, a.in[I_B1]};
        pg8::gemm_phase<EpiFf1, pg8::StaticOrder, PG8_ALIGN, PG8_SP2>(lds, g, S, E);
    }
    for (int rep_ = 0; rep_ < SYNC_REP; ++rep_) xcd_barrier(bar);
    {
        pg8::StaticOrder S; S.init(M, D, G, (int)blockIdx.x);
        pg8::Gemm g{U, W2_t, M, D, FF}; EpiZ2 E{a.out, a.in[I_B2]};
        pg8::gemm_phase<EpiZ2, pg8::StaticOrder, PG8_ALIGN, PG8_SP2>(lds, g, S, E);
    }
    for (int rep_ = 0; rep_ < SYNC_REP; ++rep_) xcd_barrier(bar);
    for (int m = gw; m < M; m += NGW) ln_row<true, false, false>(a.out + (size_t)m * D, a.in[I_LN2G], a.in[I_LN2B], a.out + (size_t)m * D, nullptr, nullptr, lane);
}

#ifndef NAIVE_ATTN
#define NAIVE_ATTN 0
#endif
extern "C" void kernel_launch(void* const* d_in, const int* in_sizes, int n_in, void* d_out, int out_size, void* d_ws, size_t ws_size, hipStream_t stream) {
    static int grid = 0;
    if (grid == 0) {
        if (n_in != 19 || in_sizes[0] != M * D || out_size != M * D || ws_size < WS_END) { fprintf(stderr, "kernel_launch: unexpected shapes (n_in %d, in0 %d, out %d, ws %zu)\n", n_in, n_in > 0 ? in_sizes[0] : -1, out_size, ws_size); grid = -1; return; }
        int dev = 0, cus = 0, per_cu = 0;
        (void)hipGetDevice(&dev); (void)hipDeviceGetAttribute(&cus, hipDeviceAttributeMultiprocessorCount, dev);
        (void)hipFuncSetAttribute((const void*)fwd_kernel, hipFuncAttributeMaxDynamicSharedMemorySize, LDS_BYTES);
        (void)hipOccupancyMaxActiveBlocksPerMultiprocessor(&per_cu, (const void*)fwd_kernel, NTHREADS, LDS_BYTES);
        if (per_cu < 1) per_cu = 1;
        grid = cus * per_cu;
        (void)hipGetLastError();
    }
    if (grid < 0) return;
    if (hipMemsetAsync((char*)d_ws + WS_BAR, 0, BAR_BYTES, stream) != hipSuccess) { fprintf(stderr, "kernel_launch: memset of the barrier words failed\n"); return; }
    Args a{};
    for (int i = 0; i < 19; ++i) a.in[i] = (const float*)d_in[i];
    a.out = (float*)d_out; a.ws = (unsigned char*)d_ws; a.naive = NAIVE_ATTN; a.pad = 0;
    void* params[] = {&a};
    hipError_t e = hipLaunchCooperativeKernel((const void*)fwd_kernel, dim3(grid), dim3(NTHREADS), params, LDS_BYTES, stream);
    if (e != hipSuccess) fprintf(stderr, "cooperative launch failed: %s (grid %d)\n", hipGetErrorString(e), grid);
}
```
